# Optimizing an MI355X kernel written in HIP

```python
import math
import jax
import jax.numpy as jnp
from jax import lax
import numpy as np

D_MODEL = 2048
BATCH = 4
SEQ = 2048
DEPTH = 1

CTX_LEN = 256
GRID_W = 64
HEAD_DIM = 128
A_HEADS = D_MODEL // HEAD_DIM
KV_HEADS = A_HEADS // 4
Q_BLOCK = 128
ROPE_THETA = 10000.0
ROPE_PAIRS_AXIS = HEAD_DIM // 4
M_HEADS = 4
MV_DIM = D_MODEL // M_HEADS
MQK_DIM = MV_DIM // 2
M_CHUNK = 64
N_EXPERTS = 32
TOP_K = 4
D_FF = D_MODEL
SWIGLU_LIMIT = 7.0
SWIGLU_ALPHA = 1.702
EXPERT_BLOCK = 128
EPS = 1e-6

IN_SPLITS = (
    M_HEADS * MQK_DIM,
    M_HEADS * MQK_DIM,
    M_HEADS * MV_DIM,
    M_HEADS * MV_DIM,
    4 * M_HEADS,
    A_HEADS * HEAD_DIM,
    KV_HEADS * HEAD_DIM,
    KV_HEADS * HEAD_DIM,
    2 * D_MODEL,
)
F_IN = sum(IN_SPLITS)

kernel_name = 'hybrid_mlstm_gqa_moe_diffusion_block'


def rmsnorm(x, g):
    xf = x.astype(jnp.float32)
    y = xf * lax.rsqrt(jnp.mean(xf * xf, axis=-1, keepdims=True) + EPS)
    return (y * g.astype(jnp.float32)).astype(x.dtype)


def split_in(p):
    parts, start = [], 0
    for size in IN_SPLITS:
        parts.append(p[..., start:start + size])
        start += size
    return parts


def axial_rope_tables(n_tokens):
    rows = n_tokens // GRID_W
    row_ids = jnp.repeat(jnp.arange(rows), GRID_W).astype(jnp.float32)
    col_ids = jnp.tile(jnp.arange(GRID_W), rows).astype(jnp.float32)
    freqs = jnp.exp(-math.log(ROPE_THETA) * jnp.arange(ROPE_PAIRS_AXIS, dtype=jnp.float32) / ROPE_PAIRS_AXIS)
    ang = jnp.concatenate([row_ids[:, None] * freqs, col_ids[:, None] * freqs], axis=-1)
    return jnp.cos(ang), jnp.sin(ang)


def apply_rope(x, cos, sin):
    xf = x.astype(jnp.float32).reshape(x.shape[:-1] + (HEAD_DIM // 2, 2))
    x0, x1 = xf[..., 0], xf[..., 1]
    co, si = cos[None, :, None, :], sin[None, :, None, :]
    out = jnp.stack([x0 * co - x1 * si, x0 * si + x1 * co], axis=-1)
    return out.reshape(x.shape).astype(x.dtype)


def blocked_attention(q, k, v):
    n_b, n_t = q.shape[:2]
    n_blk = n_t // Q_BLOCK
    qb = q.reshape(n_b, n_blk, Q_BLOCK, KV_HEADS, A_HEADS // KV_HEADS, HEAD_DIM).transpose(1, 0, 2, 3, 4, 5)
    scale = HEAD_DIM ** -0.5

    def one_block(qi):
        s = jnp.einsum('bqkgd,bnkd->bkgqn', qi, k, preferred_element_type=jnp.float32) * scale
        p = jax.nn.softmax(s, axis=-1).astype(v.dtype)
        return jnp.einsum('bkgqn,bnkd->bqkgd', p, v)

    o = lax.map(one_block, qb)
    return o.transpose(1, 0, 2, 3, 4, 5).reshape(n_b, n_t, A_HEADS * HEAD_DIM)


def mlstm_inputs(pp):
    n_b, n_t = pp[0].shape[:2]

    def heads(a, d):
        return a.astype(jnp.float32).reshape(n_b, n_t, M_HEADS, d).transpose(0, 2, 1, 3)

    q = heads(pp[0], MQK_DIM) * (MQK_DIM ** -0.5)
    k = heads(pp[1], MQK_DIM)
    v = heads(pp[2], MV_DIM)
    gates = pp[4].astype(jnp.float32).reshape(n_b, n_t, 4, M_HEADS).transpose(2, 0, 3, 1)
    i_f, f_f, i_b, f_b = gates[0], gates[1], gates[2], gates[3]
    return (q, k, v, i_f, jax.nn.log_sigmoid(f_f)), (q, k, v, i_b, jax.nn.log_sigmoid(f_b))


def mlstm_chunkwise(q, k, v, ig, lf, state):
    n_b, n_h, n_t, _ = q.shape
    n_chunk = n_t // M_CHUNK

    def chunks(a):
        return jnp.moveaxis(a.reshape(a.shape[:2] + (n_chunk, M_CHUNK) + a.shape[3:]), 2, 0)

    tril = jnp.tril(jnp.ones((M_CHUNK, M_CHUNK), dtype=bool))

    def step(carry, inp):
        c_mat, n_vec, m = carry
        qc, kc, vc, igc, lfc = inp
        b = jnp.cumsum(lfc, axis=-1)
        d_intra = jnp.where(tril, b[..., :, None] - b[..., None, :] + igc[..., None, :], -jnp.inf)
        d_inter = b + m[..., None]
        m_t = jnp.maximum(d_inter, jnp.max(d_intra, axis=-1))
        s = jnp.einsum('bhtd,bhsd->bhts', qc, kc) * jnp.exp(d_intra - m_t[..., None])
        w_inter = jnp.exp(d_inter - m_t)
        num = jnp.einsum('bhts,bhsv->bhtv', s, vc) + w_inter[..., None] * jnp.einsum('bhtd,bhvd->bhtv', qc, c_mat)
        den = jnp.sum(s, axis=-1) + w_inter * jnp.einsum('bhtd,bhd->bht', qc, n_vec)
        h = num / jnp.maximum(jnp.abs(den), jnp.exp(-m_t))[..., None]
        b_end = b[..., -1]
        g = b_end[..., None] - b + igc
        m_new = jnp.maximum(b_end + m, jnp.max(g, axis=-1))
        w_s = jnp.exp(g - m_new[..., None])
        w_c = jnp.exp(b_end + m - m_new)
        c_new = w_c[..., None, None] * c_mat + jnp.einsum('bhs,bhsv,bhsd->bhvd', w_s, vc, kc)
        n_new = w_c[..., None] * n_vec + jnp.einsum('bhs,bhsd->bhd', w_s, kc)
        return (c_new, n_new, m_new), h

    state, h = lax.scan(step, state, tuple(chunks(a) for a in (q, k, v, ig, lf)))
    h = jnp.moveaxis(h, 0, 2).reshape(n_b, n_h, n_t, MV_DIM)
    return h, state


def mlstm_final_state(k, v, ig, lf):
    b = jnp.cumsum(lf, axis=-1)
    b_end = b[..., -1]
    g = b_end[..., None] - b + ig
    m = jnp.maximum(b_end, jnp.max(g, axis=-1))
    w = jnp.exp(g - m[..., None])
    return (jnp.einsum('bhs,bhsv,bhsd->bhvd', w, v, k), jnp.einsum('bhs,bhsd->bhd', w, k), m)


def mlstm_direction(lat, ctx, need_ctx_out):
    if need_ctx_out:
        kc = ctx[1]
        zero = (jnp.zeros(kc.shape[:2] + (MV_DIM, MQK_DIM), jnp.float32),
                jnp.zeros(kc.shape[:2] + (MQK_DIM,), jnp.float32),
                jnp.zeros(kc.shape[:2], jnp.float32))
        h_ctx, state = mlstm_chunkwise(ctx[0], ctx[1], ctx[2], ctx[3], ctx[4], zero)
    else:
        h_ctx, state = None, mlstm_final_state(ctx[1], ctx[2], ctx[3], ctx[4])
    h_lat, _ = mlstm_chunkwise(lat[0], lat[1], lat[2], lat[3], lat[4], state)
    return h_lat, h_ctx


def flip_time(tup):
    return tuple(jnp.flip(a, axis=2) for a in tup)


def mlstm_readout(h, o_pre, g_mh):
    n_b, _, n_t, _ = h.shape
    y = rmsnorm(h, g_mh.reshape(M_HEADS, 1, MV_DIM))
    y = y.transpose(0, 2, 1, 3).reshape(n_b, n_t, M_HEADS * MV_DIM).astype(o_pre.dtype)
    return y * jax.nn.sigmoid(o_pre)


def merge_branches(gate_pre, m_out, a_out, w_br_m, w_br_a, w_out):
    g_m, g_a = jnp.split(jax.nn.sigmoid(gate_pre), 2, axis=-1)
    return (g_m * (m_out @ w_br_m) + g_a * (a_out @ w_br_a)) @ w_out


def moe_ffn(u, w_router, b_router, w_gu, b_gu, w_dn, b_dn):
    n_tok = u.shape[0]
    logits = (u @ w_router + b_router).astype(jnp.float32)
    top_logit, top_idx = lax.top_k(logits, TOP_K)
    top_w = jax.nn.softmax(top_logit, axis=-1)
    n_assign = n_tok * TOP_K
    exp_ids = top_idx.reshape(n_assign)
    tok_ids = jnp.repeat(jnp.arange(n_tok, dtype=jnp.int32), TOP_K)
    order = jnp.argsort(exp_ids)
    exp_sorted = exp_ids[order]
    counts = jnp.bincount(exp_ids, length=N_EXPERTS)
    padded = (counts + EXPERT_BLOCK - 1) // EXPERT_BLOCK * EXPERT_BLOCK
    start = jnp.cumsum(counts) - counts
    pad_end = jnp.cumsum(padded)
    pad_start = pad_end - padded
    slot = pad_start[exp_sorted] + jnp.arange(n_assign, dtype=jnp.int32) - start[exp_sorted]
    n_blocks = (n_assign + N_EXPERTS * (EXPERT_BLOCK - 1) + EXPERT_BLOCK - 1) // EXPERT_BLOCK
    n_slots = n_blocks * EXPERT_BLOCK
    slot_tok = jnp.zeros((n_slots,), jnp.int32).at[slot].set(tok_ids[order])
    slot_w = jnp.zeros((n_slots,), jnp.float32).at[slot].set(top_w.reshape(n_assign)[order])
    block_exp = jnp.minimum(jnp.searchsorted(pad_end, jnp.arange(n_blocks) * EXPERT_BLOCK, side='right'), N_EXPERTS - 1)
    xs = u[slot_tok].reshape(n_blocks, EXPERT_BLOCK, u.shape[1])

    def expert_block(args):
        xb, e = args
        gu = xb @ w_gu[e] + b_gu[e]
        gate = jnp.minimum(gu[:, :D_FF], SWIGLU_LIMIT)
        up = jnp.clip(gu[:, D_FF:], -SWIGLU_LIMIT, SWIGLU_LIMIT)
        hid = (up + 1) * gate * jax.nn.sigmoid(SWIGLU_ALPHA * gate)
        return hid @ w_dn[e] + b_dn[e]

    ys = lax.map(expert_block, (xs, block_exp)).reshape(n_slots, u.shape[1])
    return jnp.zeros_like(u).at[slot_tok].add(ys * slot_w[:, None].astype(ys.dtype))


def layer(hx, hc, c, c_ctx, need_ctx_out, cos, sin, w_mod, b_mod, g_norm1, g_norm2, w_in, b_in,
          g_q, g_k, g_mh, w_br_m, w_br_a, w_out, w_router, b_router, w_gu, b_gu, w_dn, b_dn):
    n_b, n_t, d = hx.shape
    n_c = hc.shape[1]
    mod_x = jax.nn.silu(c) @ w_mod + b_mod
    mod_c = jax.nn.silu(c_ctx) @ w_mod + b_mod
    sh1x, sc1x, gt1x, sh2x, sc2x, gt2x = [m[:, None, :] for m in jnp.split(mod_x, 6, axis=-1)]
    sh1c, sc1c, gt1c, sh2c, sc2c, gt2c = jnp.split(mod_c, 6, axis=-1)

    ux = rmsnorm(hx, g_norm1) * (1 + sc1x) + sh1x
    uc = rmsnorm(hc, g_norm1) * (1 + sc1c) + sh1c
    px = split_in(ux @ w_in + b_in)
    pc = split_in(uc @ w_in + b_in)

    qx = apply_rope(rmsnorm(px[5].reshape(n_b, n_t, A_HEADS, HEAD_DIM), g_q), cos, sin)
    kx = apply_rope(rmsnorm(px[6].reshape(n_b, n_t, KV_HEADS, HEAD_DIM), g_k), cos, sin)
    vx = px[7].reshape(n_b, n_t, KV_HEADS, HEAD_DIM)
    kc = rmsnorm(pc[6].reshape(n_b, n_c, KV_HEADS, HEAD_DIM), g_k)
    vc = pc[7].reshape(n_b, n_c, KV_HEADS, HEAD_DIM)
    ax = blocked_attention(qx, jnp.concatenate([kx, kc], axis=1), jnp.concatenate([vx, vc], axis=1))

    lat_f, lat_b = mlstm_inputs(px)
    ctx_f, ctx_b = mlstm_inputs(pc)
    hx_f, hc_f = mlstm_direction(lat_f, ctx_f, need_ctx_out)
    hx_b, hc_b = mlstm_direction(flip_time(lat_b), flip_time(ctx_b), need_ctx_out)
    mx = mlstm_readout(hx_f + jnp.flip(hx_b, axis=2), px[3], g_mh)

    hx_new = hx + gt1x * merge_branches(px[8], mx, ax, w_br_m, w_br_a, w_out)
    u2x = rmsnorm(hx_new, g_norm2) * (1 + sc2x) + sh2x
    hx_new = hx_new + gt2x * moe_ffn(u2x.reshape(-1, d), w_router, b_router, w_gu, b_gu, w_dn, b_dn).reshape(hx.shape)

    hc_new = hc
    if need_ctx_out:
        qc = rmsnorm(pc[5].reshape(n_b, n_c, A_HEADS, HEAD_DIM), g_q)
        ac = blocked_attention(qc, kc, vc)
        mc = mlstm_readout(hc_f + jnp.flip(hc_b, axis=2), pc[3], g_mh)
        hc_new = hc + gt1c * merge_branches(pc[8], mc, ac, w_br_m, w_br_a, w_out)
        u2c = rmsnorm(hc_new, g_norm2) * (1 + sc2c) + sh2c
        hc_new = hc_new + gt2c * moe_ffn(u2c.reshape(-1, d), w_router, b_router, w_gu, b_gu, w_dn, b_dn).reshape(hc.shape)
    return hx_new, hc_new


def setup_inputs(seed: int = 0) -> dict:
    key = jax.random.key(seed)
    ks = jax.random.split(key, 24)
    f32 = jnp.float32
    D = D_MODEL
    nrm = lambda k, shape, s: jax.random.normal(k, shape, f32) * s
    f_off = sum(IN_SPLITS[:4])
    forget_bias = 3.0 + 3.0 * jnp.linspace(0.0, 1.0, M_HEADS)
    b_in = nrm(ks[9], (DEPTH, F_IN), 0.01)
    b_in = b_in.at[:, f_off + M_HEADS:f_off + 2 * M_HEADS].add(forget_bias)
    b_in = b_in.at[:, f_off + 3 * M_HEADS:f_off + 4 * M_HEADS].add(forget_bias)
    return {
        'x': nrm(ks[0], (BATCH, SEQ, D), 1.0),
        'c': nrm(ks[1], (BATCH, D), 1.0),
        'ctx': nrm(ks[2], (BATCH, CTX_LEN, D), 1.0),
        'c_ctx': nrm(ks[3], (D,), 1.0),
        'w_mod': nrm(ks[4], (DEPTH, D, 6 * D), 0.5 * D ** -0.5),
        'b_mod': nrm(ks[5], (DEPTH, 6 * D), 0.01),
        'g_norm1': 1.0 + nrm(ks[6], (DEPTH, D), 0.01),
        'g_norm2': 1.0 + nrm(ks[7], (DEPTH, D), 0.01),
        'w_in': nrm(ks[8], (DEPTH, D, F_IN), D ** -0.5),
        'b_in': b_in,
        'g_q': 1.0 + nrm(ks[10], (DEPTH, HEAD_DIM), 0.01),
        'g_k': 1.0 + nrm(ks[11], (DEPTH, HEAD_DIM), 0.01),
        'g_mh': 1.0 + nrm(ks[12], (DEPTH, M_HEADS * MV_DIM), 0.01),
        'w_br_m': nrm(ks[13], (DEPTH, M_HEADS * MV_DIM, D), (M_HEADS * MV_DIM) ** -0.5),
        'w_br_a': nrm(ks[14], (DEPTH, A_HEADS * HEAD_DIM, D), (A_HEADS * HEAD_DIM) ** -0.5),
        'w_out': nrm(ks[15], (DEPTH, D, D), D ** -0.5),
        'w_router': nrm(ks[16], (DEPTH, D, N_EXPERTS), D ** -0.5),
        'b_router': nrm(ks[17], (DEPTH, N_EXPERTS), 0.01),
        'w_gu': nrm(ks[18], (DEPTH, N_EXPERTS, D, 2 * D_FF), D ** -0.5),
        'b_gu': nrm(ks[19], (DEPTH, N_EXPERTS, 2 * D_FF), 0.01),
        'w_dn': nrm(ks[20], (DEPTH, N_EXPERTS, D_FF, D), D_FF ** -0.5),
        'b_dn': nrm(ks[21], (DEPTH, N_EXPERTS, D), 0.01),
    }


def reference(x, c, ctx, c_ctx, w_mod, b_mod, g_norm1, g_norm2, w_in, b_in, g_q, g_k, g_mh,
              w_br_m, w_br_a, w_out, w_router, b_router, w_gu, b_gu, w_dn, b_dn):
    n_t = x.shape[1]
    cos, sin = axial_rope_tables(n_t)
    hx, hc = x, ctx
    for l in range(DEPTH):
        hx, hc = layer(hx, hc, c, c_ctx, l < DEPTH - 1, cos, sin, w_mod[l], b_mod[l], g_norm1[l], g_norm2[l],
                       w_in[l], b_in[l], g_q[l], g_k[l], g_mh[l], w_br_m[l], w_br_a[l], w_out[l],
                       w_router[l], b_router[l], w_gu[l], b_gu[l], w_dn[l], b_dn[l])
    return hx
```

```cpp
#include <hip/hip_runtime.h>
#include <stdint.h>
#include <stdio.h>

#define LAS __attribute__((address_space(3)))
typedef unsigned short bf16_t;
typedef short bf16x8 __attribute__((ext_vector_type(8)));
typedef short s16x4 __attribute__((ext_vector_type(4)));
typedef float f32x4 __attribute__((ext_vector_type(4)));
typedef float f32x16 __attribute__((ext_vector_type(16)));
typedef unsigned u32x4 __attribute__((ext_vector_type(4)));
typedef unsigned u32x2 __attribute__((ext_vector_type(2)));

constexpr int D = 2048, NB = 4, TSEQ = 2048, NCTXB = 256;
constexpr int NLAT = NB * TSEQ;
constexpr int NCTX = NB * NCTXB;
constexpr int NROW = NLAT + NCTX;
constexpr int F_IN = 13328, NP = 13568;
constexpr int NE = 32;
constexpr int KVLEN = TSEQ + NCTXB;
constexpr int NTHREADS = 512;
#ifndef REP_MASK
#define REP_MASK 0
#endif
constexpr float EPS = 1e-6f;

constexpr size_t al256(size_t x) { return (x + 255) & ~(size_t)255; }
constexpr size_t WS_CTL   = 0;
constexpr size_t CTL_BYTES = 65536;
constexpr size_t WS_MOD   = WS_CTL + CTL_BYTES;
constexpr size_t WS_BINP  = al256(WS_MOD + 5 * 12288 * 4);
constexpr size_t WS_WTIN  = al256(WS_BINP + NP * 4);
constexpr size_t WS_WTBRM = al256(WS_WTIN + (size_t)NP * D * 2);
constexpr size_t WS_WTBRA = WS_WTBRM + (size_t)D * D * 2;
constexpr size_t WS_WTOUT = WS_WTBRA + (size_t)D * D * 2;
constexpr size_t WS_WTGU  = WS_WTOUT + (size_t)D * D * 2;
constexpr size_t WS_WTDN  = WS_WTGU + (size_t)NE * 4096 * D;
constexpr size_t WS_U     = WS_WTDN + (size_t)NE * D * D;
constexpr size_t WS_PM    = WS_U + (size_t)NROW * D * 2;
constexpr size_t WS_GATES = WS_PM + (size_t)NROW * 6144 * 2;
constexpr size_t WS_AQ    = al256(WS_GATES + (size_t)NROW * 16 * 4);
constexpr size_t WS_AK    = WS_AQ + (size_t)NLAT * D * 2;
constexpr size_t WS_VV    = WS_AK + (size_t)NROW * 512 * 2;
constexpr size_t WS_KR    = WS_VV + (size_t)NROW * 512 * 2;
constexpr size_t WS_QR    = WS_KR + (size_t)NROW * 512 * 2;
constexpr size_t WS_MG    = WS_QR + (size_t)NLAT * D * 2;
constexpr size_t WS_AO    = WS_MG + (size_t)NLAT * 4096 * 2;
constexpr size_t WS_HF    = WS_AO + (size_t)NLAT * D * 2;
constexpr size_t WS_HB    = WS_HF + (size_t)NLAT * D * 2;
constexpr size_t WS_MX    = WS_HB + (size_t)NLAT * D * 2;
constexpr size_t WS_MRG   = WS_MX + (size_t)NLAT * D * 2;
constexpr size_t WS_U2    = WS_MRG + (size_t)NLAT * D * 2;
constexpr size_t WS_TOPE  = WS_U2 + (size_t)NLAT * D;
constexpr size_t WS_TOPP  = WS_TOPE + (size_t)NLAT * 4 * 4;
constexpr size_t WS_TOPW  = WS_TOPP + (size_t)NLAT * 4 * 4;
constexpr size_t WS_LIST  = WS_TOPW + (size_t)NLAT * 4 * 4;
constexpr int    MAXROWS  = 40960;
constexpr size_t WS_HID   = WS_LIST + (size_t)NE * NLAT * 4;
constexpr size_t WS_Y     = WS_HID + (size_t)MAXROWS * D;
constexpr size_t WS_WTIN8 = WS_Y + (size_t)MAXROWS * D * 2;
constexpr size_t WS_U8    = WS_WTIN8 + (size_t)11264 * D;
constexpr size_t WS_W8BRM = WS_U8 + (size_t)NROW * D;
constexpr size_t WS_W8BRA = WS_W8BRM + (size_t)D * D;
constexpr size_t WS_W8OUT = WS_W8BRA + (size_t)D * D;
constexpr size_t WS_MX8   = WS_W8OUT + (size_t)D * D;
constexpr size_t WS_AO8   = WS_MX8 + (size_t)NLAT * D;
constexpr size_t WS_MRG8  = WS_AO8 + (size_t)NLAT * D;
constexpr size_t WS_ROPE  = WS_MRG8 + (size_t)NLAT * D;
constexpr size_t WS_HX1   = WS_ROPE + 4096 * 4;
constexpr size_t WS_END   = WS_HX1 + (size_t)NLAT * D * 2;

constexpr int CW_BAR = 0;
constexpr int CW_CNT = 4096;

constexpr int LDS_TOTAL = 144 * 1024;
constexpr int XS_OFF    = 136 * 1024;
constexpr int MISC_OFF  = 135 * 1024;

__device__ __forceinline__ unsigned cvt_pk_bf16(float lo, float hi) { unsigned r; asm volatile("v_cvt_pk_bf16_f32 %0, %1, %2" : "=v"(r) : "v"(lo), "v"(hi)); return r; }
__device__ __forceinline__ float bf_lo(unsigned w) { return __uint_as_float(w << 16); }
__device__ __forceinline__ float bf_hi(unsigned w) { return __uint_as_float(w & 0xffff0000u); }
__device__ __forceinline__ float bf_s(unsigned short h) { return __uint_as_float(((unsigned)h) << 16); }
__device__ __forceinline__ float wave_sum(float v) {
    v += __int_as_float(__builtin_amdgcn_update_dpp(0, __float_as_int(v), 0xB1, 0xf, 0xf, false));
    v += __int_as_float(__builtin_amdgcn_update_dpp(0, __float_as_int(v), 0x4E, 0xf, 0xf, false));
    v += __int_as_float(__builtin_amdgcn_update_dpp(0, __float_as_int(v), 0x141, 0xf, 0xf, false));
    v += __int_as_float(__builtin_amdgcn_update_dpp(0, __float_as_int(v), 0x140, 0xf, 0xf, false));
    v += __int_as_float(__builtin_amdgcn_update_dpp(0, __float_as_int(v), 0x142, 0xa, 0xf, false));
    v += __int_as_float(__builtin_amdgcn_update_dpp(0, __float_as_int(v), 0x143, 0xc, 0xf, false));
    return __int_as_float(__builtin_amdgcn_readlane(__float_as_int(v), 63));
}
__device__ __forceinline__ float wave_max(float v) {
    v = fmaxf(v, __int_as_float(__builtin_amdgcn_update_dpp(__float_as_int(v), __float_as_int(v), 0xB1, 0xf, 0xf, false)));
    v = fmaxf(v, __int_as_float(__builtin_amdgcn_update_dpp(__float_as_int(v), __float_as_int(v), 0x4E, 0xf, 0xf, false)));
    v = fmaxf(v, __int_as_float(__builtin_amdgcn_update_dpp(__float_as_int(v), __float_as_int(v), 0x141, 0xf, 0xf, false)));
    v = fmaxf(v, __int_as_float(__builtin_amdgcn_update_dpp(__float_as_int(v), __float_as_int(v), 0x140, 0xf, 0xf, false)));
    v = fmaxf(v, __int_as_float(__builtin_amdgcn_update_dpp(__float_as_int(v), __float_as_int(v), 0x142, 0xa, 0xf, false)));
    v = fmaxf(v, __int_as_float(__builtin_amdgcn_update_dpp(__float_as_int(v), __float_as_int(v), 0x143, 0xc, 0xf, false)));
    return __int_as_float(__builtin_amdgcn_readlane(__float_as_int(v), 63));
}
__device__ __forceinline__ int lane_id_() { int l; asm volatile("v_mbcnt_lo_u32_b32 %0, -1, 0\n\tv_mbcnt_hi_u32_b32 %0, -1, %0" : "=v"(l)); return l; }
__device__ __forceinline__ float wave_scan_add(float v) {
    v += __int_as_float(__builtin_amdgcn_update_dpp(0, __float_as_int(v), 0x111, 0xf, 0xf, false));
    v += __int_as_float(__builtin_amdgcn_update_dpp(0, __float_as_int(v), 0x112, 0xf, 0xf, false));
    v += __int_as_float(__builtin_amdgcn_update_dpp(0, __float_as_int(v), 0x114, 0xf, 0xf, false));
    v += __int_as_float(__builtin_amdgcn_update_dpp(0, __float_as_int(v), 0x118, 0xf, 0xf, false));
    v += __int_as_float(__builtin_amdgcn_update_dpp(0, __float_as_int(v), 0x142, 0xa, 0xf, false));
    v += __int_as_float(__builtin_amdgcn_update_dpp(0, __float_as_int(v), 0x143, 0xc, 0xf, false));
    return v;
}
__device__ __forceinline__ float wave_scan_max(float v) {
    const int NI = (int)0xff800000u;
    v = fmaxf(v, __int_as_float(__builtin_amdgcn_update_dpp(NI, __float_as_int(v), 0x111, 0xf, 0xf, false)));
    v = fmaxf(v, __int_as_float(__builtin_amdgcn_update_dpp(NI, __float_as_int(v), 0x112, 0xf, 0xf, false)));
    v = fmaxf(v, __int_as_float(__builtin_amdgcn_update_dpp(NI, __float_as_int(v), 0x114, 0xf, 0xf, false)));
    v = fmaxf(v, __int_as_float(__builtin_amdgcn_update_dpp(NI, __float_as_int(v), 0x118, 0xf, 0xf, false)));
    v = fmaxf(v, __int_as_float(__builtin_amdgcn_update_dpp(NI, __float_as_int(v), 0x142, 0xa, 0xf, false)));
    v = fmaxf(v, __int_as_float(__builtin_amdgcn_update_dpp(NI, __float_as_int(v), 0x143, 0xc, 0xf, false)));
    return v;
}
__device__ __forceinline__ float sum8_dpp(float v) {
    v += __int_as_float(__builtin_amdgcn_update_dpp(0, __float_as_int(v), 0xB1, 0xf, 0xf, false));
    v += __int_as_float(__builtin_amdgcn_update_dpp(0, __float_as_int(v), 0x4E, 0xf, 0xf, false));
    v += __int_as_float(__builtin_amdgcn_update_dpp(0, __float_as_int(v), 0x141, 0xf, 0xf, false));
    return v;
}
__device__ __forceinline__ float sigmoidf_(float x) { return __builtin_amdgcn_rcpf(1.f + __expf(-x)); }

__device__ __forceinline__ unsigned pk4_fp8(float a, float b, float c, float d) {
    int w = 0;
    w = __builtin_amdgcn_cvt_pk_fp8_f32(a, b, w, false);
    w = __builtin_amdgcn_cvt_pk_fp8_f32(c, d, w, true);
    return (unsigned)w;
}
constexpr float WSCALE = 32.f, WINV = 1.f / 32.f;

#define XB_TMO      128
#define XB_XCNT(j)  (256  + 64 * (j))
#define XB_XSUB(j)  (1280 + 64 * (j))
#define XB_XGEN(j)  (2304 + 64 * (j))
#define XB_TOP      3328
#define XB_TOPGEN   3392
#define XCD_BAR_WORDS 3456
#define XB_SPIN_CAP (1u << 22)

__device__ __forceinline__ unsigned xb_ld(unsigned* p)              { return __hip_atomic_load(p, __ATOMIC_RELAXED, __HIP_MEMORY_SCOPE_AGENT); }
__device__ __forceinline__ unsigned xb_add(unsigned* p, unsigned v) { return __hip_atomic_fetch_add(p, v, __ATOMIC_RELAXED, __HIP_MEMORY_SCOPE_AGENT); }
__device__ __forceinline__ unsigned xb_xcc_id() { return (unsigned)__builtin_amdgcn_s_getreg((3 << 11) | 20) & 0xFu; }
#define XB_SPIN(cond, bar) do { unsigned _sp = 0; while (cond) { __builtin_amdgcn_s_sleep(1); \
    if ((++_sp & 255u) == 0u) { if (xb_ld(&(bar)[XB_TMO])) break; if (_sp > XB_SPIN_CAP) { atomicAdd(&(bar)[XB_TMO], 1u); break; } } } } while (0)

struct XcdBarrier { unsigned* bar; unsigned x; volatile LAS unsigned* st; };

__device__ __forceinline__ XcdBarrier xcd_barrier_post(unsigned* bar, volatile LAS unsigned* st, bool leader) {
    XcdBarrier b; b.bar = bar; b.x = xb_xcc_id(); b.st = st;
    if (leader) (void)xb_add(&bar[XB_XCNT(b.x)], 1u);
    return b;
}
__device__ __forceinline__ void xcd_barrier_complete(unsigned* bar, unsigned x, unsigned& nloc, unsigned& nx) {
    const unsigned G = gridDim.x * gridDim.y * gridDim.z;
    unsigned sum, cnt, mine, sp = 0u;
    for (;;) {
        sum = 0u; cnt = 0u; mine = 0u;
#pragma unroll
        for (unsigned j = 0; j < 16; ++j) { const unsigned c = xb_ld(&bar[XB_XCNT(j)]); sum += c; cnt += (c > 0u) ? 1u : 0u; mine = (j == x) ? c : mine; }
        if (sum == G) break;
        __builtin_amdgcn_s_sleep(1);
        if ((++sp & 255u) == 0u) { if (xb_ld(&bar[XB_TMO])) break; if (sp > XB_SPIN_CAP) { atomicAdd(&bar[XB_TMO], 1u); break; } }
    }
    nloc = mine > 0u ? mine : 1u; nx = cnt > 0u ? cnt : 1u;
}
__device__ __forceinline__ void xcd_barrier(const XcdBarrier& b, int wave_) {
    asm volatile("s_waitcnt vmcnt(0)" ::: "memory");
    __syncthreads();
    if (wave_ == 0 && lane_id_() == 0) {
        unsigned* bar = b.bar;
        __builtin_amdgcn_s_waitcnt(0);
        unsigned nloc = b.st[0], nx = b.st[1];
        if (nloc == 0u) { xcd_barrier_complete(bar, b.x, nloc, nx); b.st[0] = nloc; b.st[1] = nx; }
        const unsigned old = xb_add(&bar[XB_XSUB(b.x)], 1u);
        const unsigned gen = old / nloc;
        if (old + 1u == (gen + 1u) * nloc) {
            __builtin_amdgcn_fence(__ATOMIC_RELEASE, "agent");
            asm volatile("s_waitcnt vmcnt(0)" ::: "memory");
            const unsigned og = xb_add(&bar[XB_TOP], 1u);
            const unsigned tg = og / nx;
            if (og + 1u == (tg + 1u) * nx) xb_add(&bar[XB_TOPGEN], 1u);
            else XB_SPIN(xb_ld(&bar[XB_TOPGEN]) == tg, bar);
            __builtin_amdgcn_fence(__ATOMIC_ACQUIRE, "agent");
            xb_add(&bar[XB_XGEN(b.x)], 1u);
            asm volatile("s_waitcnt vmcnt(0)" ::: "memory");
        } else {
            XB_SPIN(xb_ld(&bar[XB_XGEN(b.x)]) == gen, bar);
            __builtin_amdgcn_fence(__ATOMIC_ACQUIRE, "agent");
            asm volatile("s_waitcnt vmcnt(0)" ::: "memory");
        }
    }
    __syncthreads();
}

struct Args {
    const float* in[22];
    float* out;
    unsigned char* ws;
    int ph_lo, ph_hi;
};

namespace g8 {
constexpr int BM = 256, BK = 64, HALF = 128, HTB = HALF * BK * 2, STAGE_BYTES = 8 * HTB;
__device__ __forceinline__ int lds_byte(int r, int c) { const int st = (r >> 4) * 2 + (c >> 5), rr = r & 15, cc = c & 31, ob = rr * 64 + cc * 2; return st * 1024 + (ob ^ (((ob >> 9) & 1) << 5)); }
__device__ __forceinline__ void stage_rc(int b, int& R, int& C) { const int st = b / 1024, sb = b % 1024, swz = sb ^ (((sb >> 9) & 1) << 5); R = (st >> 1) * 16 + swz / 64; C = (st & 1) * 32 + (swz % 64) / 2; }
__device__ __forceinline__ int perm32(int rho) { const int n = rho >> 4, i = rho & 15; return 8 * (i >> 2) + 4 * n + (i & 3); }

struct Unit { int pm, pn, e, mt, hm; };
typedef f32x4 Acc[2][2][4][2];
typedef int v8i __attribute__((ext_vector_type(8)));
typedef int v4i __attribute__((ext_vector_type(4)));
__device__ __forceinline__ void mfma8(f32x4& acc, v8i a, v8i b, int sc) {
    (void)sc;
    asm volatile("v_mfma_f32_16x16x128_f8f6f4 %0, %1, %2, %0" : "+v"(acc) : "v"(a), "v"(b));
}
__device__ __forceinline__ v8i cat8(bf16x8 lo, bf16x8 hi) { const v4i a = __builtin_bit_cast(v4i, lo), b = __builtin_bit_cast(v4i, hi); return __builtin_shufflevector(a, b, 0, 1, 2, 3, 4, 5, 6, 7); }

template <class Epi, class Sched, class Ops, bool FP8 = false>
__device__ __forceinline__ void gemm_phase(LAS unsigned char* lds, const int RB, const Sched& S, const Ops& G, const Epi& E, const int wave_) {
    const int wid = wave_, lane = lane_id_(), tid = wid * 64 + lane, wr = wid >> 2, wc = wid & 3, fr = lane & 15, fq = lane >> 4;
    const int nt = RB / 128;
    int R0, C0, R1, C1; stage_rc(tid * 16, R0, C0); stage_rc(tid * 16 + 8192, R1, C1);
    unsigned voffB[2];
    { const int Rb0 = Epi::PERM ? ((R0 & ~31) + perm32(R0 & 31)) : R0, Rb1 = Epi::PERM ? ((R1 & ~31) + perm32(R1 & 31)) : R1;
      voffB[0] = (unsigned)(Rb0 * RB + C0 * 2); voffB[1] = (unsigned)(Rb1 * RB + C1 * 2); }
    const size_t kstep = (size_t)128;
    const size_t hstep = (size_t)HALF * RB;
    const unsigned ldsw = (unsigned)wid * 1024u;
    const int aoff = lds_byte(wr * 64 + fr, fq * 8), boff = lds_byte(wc * 32 + fr, fq * 8);
#define G8_SA(b, h) (((b) * 2 + (h)) * HTB)
#define G8_SB(b, h) ((4 + (b) * 2 + (h)) * HTB)
#define G8_STAGE2(bufoff, gbase, v0, v1) do { \
        __builtin_amdgcn_global_load_lds((const unsigned*)((const char*)(gbase) + (v0)), (LAS unsigned*)(lds + (bufoff) + ldsw), 16, 0, 0); \
        __builtin_amdgcn_global_load_lds((const unsigned*)((const char*)(gbase) + (v1)), (LAS unsigned*)(lds + (bufoff) + ldsw + 8192), 16, 0, 0); } while (0)
#define G8_LDA(dst, b, h) do { _Pragma("unroll") for (int m = 0; m < 4; ++m) _Pragma("unroll") for (int k = 0; k < 2; ++k) dst[m][k] = *(const LAS bf16x8*)(lds + G8_SA(b, h) + aoff + m * 2048 + k * 1024); } while (0)
#define G8_LDB(dst, b, h) do { _Pragma("unroll") for (int n = 0; n < 2; ++n) _Pragma("unroll") for (int k = 0; k < 2; ++k) dst[n][k] = *(const LAS bf16x8*)(lds + G8_SB(b, h) + boff + n * 2048 + k * 1024); } while (0)
#define G8_MMA(ai, bj, At, Bt) do { __builtin_amdgcn_s_setprio(1); \
        if constexpr (FP8) { _Pragma("unroll") for (int m = 0; m < 4; ++m) _Pragma("unroll") for (int n = 0; n < 2; ++n) \
            mfma8(acc[ai][bj][m][n], cat8(Bt[n][0], Bt[n][1]), cat8(At[m][0], At[m][1]), sc1_); } \
        else { _Pragma("unroll") for (int m = 0; m < 4; ++m) _Pragma("unroll") for (int n = 0; n < 2; ++n) _Pragma("unroll") for (int k = 0; k < 2; ++k) \
            acc[ai][bj][m][n] = __builtin_amdgcn_mfma_f32_16x16x32_bf16(Bt[n][k], At[m][k], acc[ai][bj][m][n], 0, 0, 0); } \
        __builtin_amdgcn_s_setprio(0); } while (0)
#define G8_WAIT_V(n) asm volatile("s_waitcnt vmcnt(" #n ")" ::: "memory")
#define G8_WAIT_L(n) asm volatile("s_waitcnt lgkmcnt(" #n ")" ::: "memory")
#define G8_BAR __builtin_amdgcn_s_barrier()
#define G8_SCHED __builtin_amdgcn_sched_barrier(0)
    Unit cur, nxt; int ui = 0;
    if (!S.next(0, cur)) return;
    int sc1_ = 0x7F7F7F7F; asm volatile("" : "+v"(sc1_));
    Acc acc;
#pragma unroll
    for (int a = 0; a < 2; ++a)
#pragma unroll
        for (int b = 0; b < 2; ++b)
#pragma unroll
            for (int m = 0; m < 4; ++m)
#pragma unroll
                for (int n = 0; n < 2; ++n) acc[a][b][m][n] = (f32x4){0.f, 0.f, 0.f, 0.f};
    bf16x8 At[4][2], B0[2][2], B1[2][2];
    const char* cA = G.a_base(cur); const char* cB = G.b_base(cur);
    unsigned c00 = G.a_voff(cur, R0, C0), c01 = G.a_voff(cur, R1, C1), c10 = G.a_voff(cur, R0 + HALF, C0), c11 = G.a_voff(cur, R1 + HALF, C1);
    unsigned n00 = c00, n01 = c01, n10 = c10, n11 = c11;
    G8_STAGE2(G8_SB(0, 0), cB, voffB[0], voffB[1]); G8_STAGE2(G8_SA(0, 0), cA, c00, c01); G8_STAGE2(G8_SB(0, 1), cB + hstep, voffB[0], voffB[1]); G8_STAGE2(G8_SA(0, 1), cA, c10, c11);
    if (wr == 1) G8_BAR;
    G8_WAIT_V(4); G8_BAR;
    G8_STAGE2(G8_SB(1, 0), cB + kstep, voffB[0], voffB[1]); G8_STAGE2(G8_SA(1, 0), cA + kstep, c00, c01); G8_STAGE2(G8_SB(1, 1), cB + hstep + kstep, voffB[0], voffB[1]);
    G8_WAIT_V(6); G8_BAR;
    for (;;) {
        const bool has_next = S.next(ui + 1, nxt);
        const bool sk0_ = Sched::HM && cur.hm <= wr * 64, hm_ = Sched::HM && cur.hm <= 128 + wr * 64;
        const char* nA = has_next ? G.a_base(nxt) : cA; const char* nB = has_next ? G.b_base(nxt) : cB;
        int k00 = 0, k01 = 0, k10 = 0, k11 = 0;
        if constexpr (Ops::GATHER) {
            if (has_next) { k00 = G.a_key(nxt, R0); k01 = G.a_key(nxt, R1); k10 = G.a_key(nxt, R0 + HALF); k11 = G.a_key(nxt, R1 + HALF); }
        }
        for (int t = 0; t < nt; t += 2) {
            const bool last = (t == nt - 2);
            const char* a1 = cA + (size_t)(t + 1) * kstep;
            const char* a2 = last ? nA : cA + (size_t)(t + 2) * kstep; const char* b2 = last ? nB : cB + (size_t)(t + 2) * kstep;
            const char* a3 = a2 + kstep; const char* b3 = b2 + kstep;
            unsigned s00 = c00, s01 = c01, s10 = c10, s11 = c11;
            if constexpr (Ops::GATHER) { if (last) { asm volatile("" : "+v"(k00), "+v"(k01), "+v"(k10), "+v"(k11));
                    if (has_next) { n00 = G.a_off(k00, C0); n01 = G.a_off(k01, C1); n10 = G.a_off(k10, C0); n11 = G.a_off(k11, C1); }
                    else { n00 = c00; n01 = c01; n10 = c10; n11 = c11; }
                    s00 = n00; s01 = n01; s10 = n10; s11 = n11; } }
            if (!sk0_) { G8_LDB(B0, 0, 0); G8_SCHED; G8_LDA(At, 0, 0); }
            G8_STAGE2(G8_SA(1, 1), a1, c10, c11);
            G8_WAIT_L(8); G8_BAR; G8_WAIT_L(0); if (!sk0_) G8_MMA(0, 0, At, B0);
            G8_BAR; G8_SCHED;
            if (!sk0_) G8_LDB(B1, 0, 1);
            G8_STAGE2(G8_SB(0, 0), b2, voffB[0], voffB[1]);
            G8_BAR; G8_WAIT_L(0); if (!sk0_) G8_MMA(0, 1, At, B1);
            G8_BAR;
            if (!hm_) G8_LDA(At, 0, 1);
            G8_STAGE2(G8_SA(0, 0), a2, s00, s01);
            G8_BAR; G8_WAIT_L(0); if (!hm_) G8_MMA(1, 0, At, B0);
            G8_BAR; G8_SCHED;
            G8_STAGE2(G8_SB(0, 1), b2 + hstep, voffB[0], voffB[1]);
            G8_WAIT_V(6); G8_BAR; if (!hm_) G8_MMA(1, 1, At, B1);
            G8_BAR;
            if (!sk0_) { G8_LDB(B0, 1, 0); G8_SCHED; G8_LDA(At, 1, 0); }
            G8_STAGE2(G8_SA(0, 1), a2, s10, s11);
            G8_WAIT_L(8); G8_BAR; G8_WAIT_L(0); if (!sk0_) G8_MMA(0, 0, At, B0);
            G8_BAR; G8_SCHED;
            if (!sk0_) G8_LDB(B1, 1, 1);
            G8_STAGE2(G8_SB(1, 0), b3, voffB[0], voffB[1]);
            G8_BAR; G8_WAIT_L(0); if (!sk0_) G8_MMA(0, 1, At, B1);
            G8_BAR;
            if (!hm_) G8_LDA(At, 1, 1);
            G8_STAGE2(G8_SA(1, 0), a3, s00, s01);
            G8_BAR; G8_WAIT_L(0); if (!hm_) G8_MMA(1, 0, At, B0);
            G8_BAR; G8_SCHED;
            G8_STAGE2(G8_SB(1, 1), b3 + hstep, voffB[0], voffB[1]);
            G8_WAIT_V(6); G8_BAR; if (!hm_) G8_MMA(1, 1, At, B1);
            G8_BAR;
        }
        if constexpr (FP8) {
            asm volatile("s_nop 15\n\ts_nop 15" ::: "memory");
#pragma unroll
            for (int a = 0; a < 2; ++a)
#pragma unroll
                for (int b = 0; b < 2; ++b)
#pragma unroll
                    for (int m = 0; m < 4; ++m) asm volatile("" : "+v"(acc[a][b][m][0]), "+v"(acc[a][b][m][1]));
        }
        E(acc, cur, wr, wc, fr, fq);
        if (!has_next) break;
        if (!E.keep_acc(cur)) {
#pragma unroll
            for (int a = 0; a < 2; ++a)
#pragma unroll
                for (int b = 0; b < 2; ++b)
#pragma unroll
                    for (int m = 0; m < 4; ++m)
#pragma unroll
                        for (int n = 0; n < 2; ++n) acc[a][b][m][n] = (f32x4){0.f, 0.f, 0.f, 0.f};
        }
        cur = nxt; cA = nA; cB = nB; ++ui;
        if (Ops::GATHER) { c00 = n00; c01 = n01; c10 = n10; c11 = n11; }
    }
    G8_WAIT_V(0);
    if (wr == 0) G8_BAR;
    G8_BAR;
#undef G8_SA
#undef G8_SB
#undef G8_STAGE2
#undef G8_LDA
#undef G8_LDB
#undef G8_MMA
#undef G8_WAIT_V
#undef G8_WAIT_L
#undef G8_BAR
#undef G8_SCHED
}

struct OpsPlain {
    static constexpr bool GATHER = false;
    const bf16_t* A; const bf16_t* Bt; int K;
    __device__ __forceinline__ const char* a_base(const Unit& u) const { return (const char*)A + (size_t)u.pm * 256 * K * 2; }
    __device__ __forceinline__ const char* b_base(const Unit& u) const { return (const char*)Bt + (size_t)u.pn * 256 * K * 2; }
    __device__ __forceinline__ unsigned a_voff(const Unit&, int R, int C) const { return (unsigned)(R * K + C) * 2u; }
};
__device__ __forceinline__ void tile_order(int L, int nM, int nN, int& pm, int& pn) {
    const int nwg = nM * nN; int wgid = L;
    { const int q = nwg / 8, r = nwg % 8, xcd = wgid % 8, off = wgid / 8; wgid = (xcd < r ? xcd * (q + 1) : r * (q + 1) + (xcd - r) * q) + off; }
    const int nig = 8 * nN, gid = wgid / nig, fm = gid * 8, gsz = (nM - fm) < 8 ? (nM - fm) : 8;
    pm = fm + ((wgid % nig) % gsz); pn = (wgid % nig) / gsz;
}
}

struct SchedInprojA {
    static constexpr bool HM = false;
    int G, c;
    __device__ __forceinline__ bool next(int i, g8::Unit& u) const {
        const int L = i * G + c; int j;
        u.e = 0; u.mt = 0; u.hm = 256;
        if (L < 32 * 9) { g8::tile_order(L, 32, 9, u.pm, j); u.pn = j < 8 ? j : 52; return true; }
        const int Lc = L - 32 * 9;
        if (Lc >= 4 * 5) return false;
        j = Lc >> 2; u.pm = 32 + (Lc & 3); u.pn = j < 4 ? 4 + j : 52;
        return true;
    }
};
struct SchedInprojB {
    static constexpr bool HM = false;
    int G, c;
    __device__ __forceinline__ bool next(int i, g8::Unit& u) const {
        const int L = i * G + c; int j;
        u.e = 0; u.mt = 0; u.hm = 256;
        if (L < 32 * 44) { g8::tile_order(L, 32, 44, u.pm, j); u.pn = 8 + j; return true; }
        const int Lc = L - 32 * 44;
        if (Lc >= 4 * 12) return false;
        j = Lc >> 2; u.pm = 32 + (Lc & 3); u.pn = j < 8 ? 8 + j : 24 + j;
        return true;
    }
};
struct OpsPlain8 {
    static constexpr bool GATHER = false;
    const unsigned char* A; const unsigned char* Bt; int pn0;
    __device__ __forceinline__ const char* a_base(const g8::Unit& u) const { return (const char*)A + (size_t)u.pm * 256 * D; }
    __device__ __forceinline__ const char* b_base(const g8::Unit& u) const { return (const char*)Bt + (size_t)(u.pn - pn0) * 256 * D; }
    __device__ __forceinline__ unsigned a_voff(const g8::Unit&, int R, int C) const { return (unsigned)(R * D + C * 2); }
};
template <bool HN>
struct EpiInprojT {
    static constexpr bool PERM = true;
    bf16_t* PM; bf16_t* QR; bf16_t* KR; bf16_t* VV; unsigned char* MG; unsigned char* OG8; float* GATES; const float* bias; float accs;
    const float* g_q; const float* g_k; const float* ROPE; LAS unsigned char* lds;
    __device__ __forceinline__ bool keep_acc(const g8::Unit&) const { return false; }
    __device__ __forceinline__ void operator()(const g8::Acc& acc, const g8::Unit& u, int wr, int wc, int fr, int fq) const {
        const int row0 = u.pm * 256 + wr * 64 + fr, pn = u.pn;
        const int cl0 = wc * 32 + 8 * fq;
        const float* bp = bias + pn * 256 + cl0;
        if (pn == 52) {
            if (wc == 0 && fq < 2) {
                const f32x4 b0 = *(const f32x4*)(bp), b1 = *(const f32x4*)(bp + 4);
#pragma unroll
                for (int ai = 0; ai < 2; ++ai)
#pragma unroll
                    for (int m = 0; m < 4; ++m) {
                        float* gp = GATES + (size_t)(row0 + ai * 128 + m * 16) * 16 + 8 * fq;
                        *(f32x4*)gp = acc[ai][0][m][0] * accs + b0; *(f32x4*)(gp + 4) = acc[ai][0][m][1] * accs + b1;
                    }
            }
            return;
        }
        if constexpr (HN) {
            if (pn >= 24 && pn < 34) {
                const bool isq = pn < 32, lat = u.pm < 32;
                LAS float* xs = (LAS float*)(lds + XS_OFF);
                f32x4 bb[2][2];
#pragma unroll
                for (int bj = 0; bj < 2; ++bj) { bb[bj][0] = *(const f32x4*)(bp + bj * 128); bb[bj][1] = *(const f32x4*)(bp + bj * 128 + 4); }
#pragma unroll
                for (int bj = 0; bj < 2; ++bj)
#pragma unroll
                    for (int ai = 0; ai < 2; ++ai)
#pragma unroll
                        for (int m = 0; m < 4; ++m) {
                            const f32x4 v0 = acc[ai][bj][m][0] * accs + bb[bj][0], v1 = acc[ai][bj][m][1] * accs + bb[bj][1];
                            float ss = v0[0] * v0[0] + v0[1] * v0[1] + v0[2] * v0[2] + v0[3] * v0[3] + v1[0] * v1[0] + v1[1] * v1[1] + v1[2] * v1[2] + v1[3] * v1[3];
                            { auto r_ = __builtin_amdgcn_permlane16_swap(__float_as_uint(ss), __float_as_uint(ss), false, false); ss = __uint_as_float(r_[0]) + __uint_as_float(r_[1]); }
                            { auto r_ = __builtin_amdgcn_permlane32_swap(__float_as_uint(ss), __float_as_uint(ss), false, false); ss = __uint_as_float(r_[0]) + __uint_as_float(r_[1]); }
                            if (fq == 0) xs[(bj * 256 + ai * 128 + wr * 64 + m * 16 + fr) * 4 + wc] = ss;
                        }
                __syncthreads();
                const float* gp = (isq ? g_q : g_k) + cl0;
                const f32x4 gw0 = *(const f32x4*)gp, gw1 = *(const f32x4*)(gp + 4);
#pragma unroll
                for (int ai = 0; ai < 2; ++ai)
#pragma unroll
                    for (int m = 0; m < 4; ++m) {
                        const int row = row0 + ai * 128 + m * 16, rl = ai * 128 + wr * 64 + m * 16 + fr;
                        f32x4 c4 = (f32x4){1.f, 1.f, 1.f, 1.f}, s4 = (f32x4){0.f, 0.f, 0.f, 0.f};
                        int krow;
                        if (lat) {
                            const int t = row & 2047, pos = (cl0 < 64) ? (t >> 6) : (t & 63);
                            const float* rp = ROPE + pos * 32 + ((cl0 >> 1) & 31);
                            c4 = *(const f32x4*)rp; s4 = *(const f32x4*)(rp + 2048);
                            krow = row + (row >> 11) * 256;
                        } else { const int j = row - NLAT; krow = (j >> 8) * KVLEN + TSEQ + (j & 255); }
#pragma unroll
                        for (int bj = 0; bj < 2; ++bj) {
                            const f32x4 tot = *(const LAS f32x4*)(xs + (bj * 256 + rl) * 4);
                            const float rstd = rsqrtf((tot[0] + tot[1] + tot[2] + tot[3]) * (1.f / 128.f) + EPS);
                            const f32x4 y0 = (acc[ai][bj][m][0] * accs + bb[bj][0]) * rstd * gw0, y1 = (acc[ai][bj][m][1] * accs + bb[bj][1]) * rstd * gw1;
                            u32x4 w;
                            w.x = cvt_pk_bf16(y0[0] * c4[0] - y0[1] * s4[0], y0[0] * s4[0] + y0[1] * c4[0]);
                            w.y = cvt_pk_bf16(y0[2] * c4[1] - y0[3] * s4[1], y0[2] * s4[1] + y0[3] * c4[1]);
                            w.z = cvt_pk_bf16(y1[0] * c4[2] - y1[1] * s4[2], y1[0] * s4[2] + y1[1] * c4[2]);
                            w.w = cvt_pk_bf16(y1[2] * c4[3] - y1[3] * s4[3], y1[2] * s4[3] + y1[3] * c4[3]);
                            bf16_t* dp = isq ? QR + (size_t)row * 2048 + (pn - 24) * 256 + bj * 128 + cl0 : KR + (size_t)krow * 512 + (pn - 32) * 256 + bj * 128 + cl0;
                            *(u32x4*)dp = w;
                        }
                    }
                return;
            }
        }
        bf16_t* dst; int ldc; int mode = 0; float scale = 1.f;
        unsigned char* gdst = MG + (pn - 36) * 256; int gld = 4096;
        if (pn >= 16 && pn < 24) { dst = PM; ldc = 0; mode = 1; gdst = OG8 + (pn - 16) * 256; gld = 2048; }
        else if (pn < 24) { dst = PM + pn * 256; ldc = 6144; if (pn < 4) scale = 0.0625f; }
                else if (pn < 36) { dst = VV + (pn - 34) * 256; ldc = 512; mode = 2; }
        else { dst = PM; ldc = 0; mode = 1; }
        int rowadd = 0;
        if (mode == 2) rowadd = (u.pm < 32) ? (u.pm >> 3) * 256 : (-6144 + 2048 * (u.pm - 32));
#pragma unroll
        for (int bj = 0; bj < 2; ++bj) {
            const f32x4 b0 = *(const f32x4*)(bp + bj * 128), b1 = *(const f32x4*)(bp + bj * 128 + 4);
#pragma unroll
            for (int ai = 0; ai < 2; ++ai)
#pragma unroll
                for (int m = 0; m < 4; ++m) {
                    f32x4 v0 = (acc[ai][bj][m][0] * accs + b0) * scale, v1 = (acc[ai][bj][m][1] * accs + b1) * scale;
                    if (mode == 1) {
                        unsigned q0 = 0u, q1 = 0u;
#pragma unroll
                        for (int j = 0; j < 4; ++j) {
                            q0 = __builtin_amdgcn_cvt_pk_u8_f32(fmaxf(sigmoidf_(v0[j]) * 255.f, 1.f), j, q0);
                            q1 = __builtin_amdgcn_cvt_pk_u8_f32(fmaxf(sigmoidf_(v1[j]) * 255.f, 1.f), j, q1);
                        }
                        *(u32x2*)(gdst + (size_t)(row0 + ai * 128 + m * 16) * gld + bj * 128 + cl0) = (u32x2){q0, q1};
                        continue;
                    }
                    u32x4 w; w.x = cvt_pk_bf16(v0[0], v0[1]); w.y = cvt_pk_bf16(v0[2], v0[3]); w.z = cvt_pk_bf16(v1[0], v1[1]); w.w = cvt_pk_bf16(v1[2], v1[3]);
                    *(u32x4*)(dst + (size_t)(row0 + ai * 128 + m * 16 + rowadd) * ldc + bj * 128 + cl0) = w;
                }
        }
    }
};

struct SchedDual {
    static constexpr bool HM = false;
    int G, c;
    __device__ __forceinline__ bool next(int i, g8::Unit& u) const {
        const int L = (i >> 1) * G + c;
        if (L >= 256) return false;
        g8::tile_order(L, 32, 8, u.pm, u.pn); u.e = i & 1; u.mt = 0; u.hm = 256; return true;
    }
};
constexpr float AO_SCALE = 8.f, MRG_SCALE = 4.f;
struct OpsDual {
    static constexpr bool GATHER = false;
    const unsigned char* A0; const unsigned char* A1; const unsigned char* B0; const unsigned char* B1;
    __device__ __forceinline__ const char* a_base(const g8::Unit& u) const { return (const char*)(u.e ? A1 : A0) + (size_t)u.pm * 256 * D; }
    __device__ __forceinline__ const char* b_base(const g8::Unit& u) const { return (const char*)(u.e ? B1 : B0) + (size_t)u.pn * 256 * D; }
    __device__ __forceinline__ unsigned a_voff(const g8::Unit&, int R, int C) const { return (unsigned)(R * D + C * 2); }
};
struct EpiMerge {
    static constexpr bool PERM = true;
    const unsigned char* MG; unsigned char* OUT;
    __device__ __forceinline__ bool keep_acc(const g8::Unit& u) const { return u.e == 0; }
    __device__ __forceinline__ void operator()(g8::Acc& acc, const g8::Unit& u, int wr, int wc, int fr, int fq) const {
        const int row0 = u.pm * 256 + wr * 64 + fr, col0 = u.pn * 256 + wc * 32 + 8 * fq;
        constexpr float FS = MRG_SCALE / (WSCALE * AO_SCALE * 255.f);
#define UB4(x) (f32x4){(float)((x) & 0xffu), (float)(((x) >> 8) & 0xffu), (float)(((x) >> 16) & 0xffu), (float)((x) >> 24)}
#pragma unroll
        for (int ai = 0; ai < 2; ++ai) {
            u32x2 ga[4][2], gm[4][2];
#pragma unroll
            for (int m = 0; m < 4; ++m)
#pragma unroll
                for (int bj = 0; bj < 2; ++bj) {
                    const unsigned char* gp = MG + (size_t)(row0 + ai * 128 + m * 16) * 4096 + col0 + bj * 128;
                    ga[m][bj] = *(const u32x2*)(gp + 2048);
                    if (u.e == 0) gm[m][bj] = *(const u32x2*)gp;
                }
#pragma unroll
            for (int m = 0; m < 4; ++m) {
                const size_t row = (size_t)(row0 + ai * 128 + m * 16);
#pragma unroll
                for (int bj = 0; bj < 2; ++bj) {
                    const int col = col0 + bj * 128;
                    const f32x4 a0 = UB4(ga[m][bj].x), a1 = UB4(ga[m][bj].y);
                    if (u.e == 0) {
                        const f32x4 g0 = UB4(gm[m][bj].x), g1 = UB4(gm[m][bj].y);
                        f32x4 r0, r1;
#pragma unroll
                        for (int j = 0; j < 4; ++j) { r0[j] = g0[j] * __builtin_amdgcn_rcpf(a0[j]); r1[j] = g1[j] * __builtin_amdgcn_rcpf(a1[j]); }
                        acc[ai][bj][m][0] *= r0 * AO_SCALE; acc[ai][bj][m][1] *= r1 * AO_SCALE;
                    } else {
                        const f32x4 v0 = acc[ai][bj][m][0] * FS * a0, v1 = acc[ai][bj][m][1] * FS * a1;
                        u32x2 w; w.x = pk4_fp8(v0[0], v0[1], v0[2], v0[3]); w.y = pk4_fp8(v1[0], v1[1], v1[2], v1[3]);
                        *(u32x2*)(OUT + row * 2048 + col) = w;
                    }
                }
            }
        }
#undef UB4
    }
};

struct SchedSquare {
    static constexpr bool HM = false;
    int G, c, nM, nN;
    __device__ __forceinline__ bool next(int i, g8::Unit& u) const {
        const int L = i * G + c;
        if (L >= nM * nN) return false;
        g8::tile_order(L, nM, nN, u.pm, u.pn); u.e = 0; u.mt = 0; u.hm = 256; return true;
    }
};
struct EpiOut {
    static constexpr bool PERM = true;
    const float* X; const float* MOD; bf16_t* HX; float accs;
    __device__ __forceinline__ bool keep_acc(const g8::Unit&) const { return false; }
    __device__ __forceinline__ void operator()(const g8::Acc& acc, const g8::Unit& u, int wr, int wc, int fr, int fq) const {
        const int row0 = u.pm * 256 + wr * 64 + fr, col0 = u.pn * 256 + wc * 32 + 8 * fq;
        const float* gt = MOD + (size_t)(u.pm >> 3) * 12288 + 4096 + col0;
        f32x4 g[2][2];
#pragma unroll
        for (int bj = 0; bj < 2; ++bj)
#pragma unroll
            for (int n = 0; n < 2; ++n) g[bj][n] = *(const f32x4*)(gt + bj * 128 + n * 4) * accs;
#pragma unroll
        for (int ai = 0; ai < 2; ++ai) {
            f32x4 xv[4][2][2];
#pragma unroll
            for (int m = 0; m < 4; ++m) {
                const size_t ro = (size_t)(row0 + ai * 128 + m * 16) * 2048 + col0;
#pragma unroll
                for (int bj = 0; bj < 2; ++bj)
#pragma unroll
                    for (int n = 0; n < 2; ++n) xv[m][bj][n] = *(const f32x4*)(X + ro + bj * 128 + n * 4);
            }
#pragma unroll
            for (int m = 0; m < 4; ++m) {
                const size_t ro = (size_t)(row0 + ai * 128 + m * 16) * 2048 + col0;
#pragma unroll
                for (int bj = 0; bj < 2; ++bj) {
                    const f32x4 v0 = xv[m][bj][0] + g[bj][0] * acc[ai][bj][m][0], v1 = xv[m][bj][1] + g[bj][1] * acc[ai][bj][m][1];
                    u32x4 w; w.x = cvt_pk_bf16(v0[0], v0[1]); w.y = cvt_pk_bf16(v0[2], v0[3]); w.z = cvt_pk_bf16(v1[0], v1[1]); w.w = cvt_pk_bf16(v1[2], v1[3]);
                    *(u32x4*)(HX + ro + bj * 128) = w;
                }
            }
        }
    }
};

struct SchedMoe {
    static constexpr bool HM = true;
    int G, vcu, NT; const volatile LAS int* mstart; const volatile LAS int* ecnt; const volatile LAS int* tb;
    __device__ __forceinline__ bool next(int i, g8::Unit& u) const {
        const int L = i * G + vcu, NA = tb[32] * NT;
        int e;
        if (L < NA) {
            e = tb[96 + L / NT];
            const int fs = tb[e], F = tb[e + 1] - fs, local = L - fs * NT;
            u.mt = local % F; u.pn = local / F; u.hm = 256;
        } else {
            const int Lb = L - NA;
            if (Lb >= tb[80] * NT) return false;
            const int r = Lb / NT;
            e = tb[40 + r]; u.pn = Lb - r * NT; u.mt = mstart[e + 1] - mstart[e] - 1; u.hm = ecnt[e] - u.mt * 256;
        }
        u.e = e; u.pm = mstart[e] + u.mt; return true;
    }
};
struct OpsMoe1 {
    static constexpr bool GATHER = true;
    const unsigned char* U2; const unsigned char* WT; const int* LIST; const volatile LAS int* ecnt;
    __device__ __forceinline__ const char* a_base(const g8::Unit&) const { return (const char*)U2; }
    __device__ __forceinline__ const char* b_base(const g8::Unit& u) const { return (const char*)WT + ((size_t)u.e * 4096 + (size_t)u.pn * 256) * D; }
    __device__ __forceinline__ int a_key(const g8::Unit& u, int R) const {
        const int n = ecnt[u.e]; int slot = u.mt * 256 + R; slot = slot < n ? slot : n - 1;
        return LIST[u.e * NLAT + slot];
    }
    __device__ __forceinline__ unsigned a_off(int tok, int C) const { return (unsigned)(tok * D + C * 2); }
    __device__ __forceinline__ unsigned a_voff(const g8::Unit& u, int R, int C) const { return a_off(a_key(u, R), C); }
};
struct EpiMoe1 {
    static constexpr bool PERM = true;
    unsigned char* HID; const float* bgu;
    __device__ __forceinline__ bool keep_acc(const g8::Unit&) const { return false; }
    __device__ __forceinline__ void operator()(const g8::Acc& acc, const g8::Unit& u, int wr, int wc, int fr, int fq) const {
        const int row0 = u.pm * 256 + wr * 64 + fr, j0 = u.pn * 128 + wc * 32 + 8 * fq;
        const float* bg = bgu + (size_t)u.e * 4096 + j0; const float* bu = bg + 2048;
        const f32x4 g0 = *(const f32x4*)bg, g1 = *(const f32x4*)(bg + 4), u0 = *(const f32x4*)bu, u1 = *(const f32x4*)(bu + 4);
#pragma unroll
        for (int ai = 0; ai < 2; ++ai) {
            if (u.hm <= ai * 128 + wr * 64) break;
#pragma unroll
            for (int m = 0; m < 4; ++m) {
                f32x4 ga = acc[ai][0][m][0] * WINV + g0, gb = acc[ai][0][m][1] * WINV + g1, ua = acc[ai][1][m][0] * WINV + u0, ub = acc[ai][1][m][1] * WINV + u1;
                f32x4 ha, hb;
#pragma unroll
                for (int j = 0; j < 4; ++j) {
                    const float gt = fminf(ga[j], 7.f), up = fminf(fmaxf(ua[j], -7.f), 7.f);
                    ha[j] = (up + 1.f) * gt * sigmoidf_(1.702f * gt);
                    const float gt2 = fminf(gb[j], 7.f), up2 = fminf(fmaxf(ub[j], -7.f), 7.f);
                    hb[j] = (up2 + 1.f) * gt2 * sigmoidf_(1.702f * gt2);
                }
                u32x2 w; w.x = pk4_fp8(ha[0], ha[1], ha[2], ha[3]); w.y = pk4_fp8(hb[0], hb[1], hb[2], hb[3]);
                *(u32x2*)(HID + (size_t)(row0 + ai * 128 + m * 16) * 2048 + j0) = w;
            }
        }
    }
};
struct OpsMoe2 {
    static constexpr bool GATHER = false;
    const unsigned char* HID; const unsigned char* WT;
    __device__ __forceinline__ const char* a_base(const g8::Unit& u) const { return (const char*)HID + (size_t)u.pm * 256 * D; }
    __device__ __forceinline__ const char* b_base(const g8::Unit& u) const { return (const char*)WT + ((size_t)u.e * 2048 + (size_t)u.pn * 256) * D; }
    __device__ __forceinline__ unsigned a_voff(const g8::Unit&, int R, int C) const { return (unsigned)(R * D + C * 2); }
};
struct EpiMoe2 {
    static constexpr bool PERM = true;
    bf16_t* Y; const float* bdn;
    __device__ __forceinline__ bool keep_acc(const g8::Unit&) const { return false; }
    __device__ __forceinline__ void operator()(const g8::Acc& acc, const g8::Unit& u, int wr, int wc, int fr, int fq) const {
        const int row0 = u.pm * 256 + wr * 64 + fr, col0 = u.pn * 256 + wc * 32 + 8 * fq;
        const float* bp = bdn + (size_t)u.e * 2048 + col0;
#pragma unroll
        for (int bj = 0; bj < 2; ++bj) {
            const f32x4 b0 = *(const f32x4*)(bp + bj * 128), b1 = *(const f32x4*)(bp + bj * 128 + 4);
#pragma unroll
            for (int ai = 0; ai < 2; ++ai) {
                if (u.hm <= ai * 128 + wr * 64) break;
#pragma unroll
                for (int m = 0; m < 4; ++m) {
                    const f32x4 v0 = acc[ai][bj][m][0] * WINV + b0, v1 = acc[ai][bj][m][1] * WINV + b1;
                    u32x4 w; w.x = cvt_pk_bf16(v0[0], v0[1]); w.y = cvt_pk_bf16(v0[2], v0[3]); w.z = cvt_pk_bf16(v1[0], v1[1]); w.w = cvt_pk_bf16(v1[2], v1[3]);
                    *(u32x4*)(Y + (size_t)(row0 + ai * 128 + m * 16) * 2048 + col0 + bj * 128) = w;
                }
            }
        }
    }
};

namespace att {
constexpr int DH = 128, NW = 8, QBLK = 32, KVBLK = 64;
constexpr float SCALE = 0.088388347648318440f;
constexpr float THR = 8.f;
constexpr int LDQ = 2048, LDK = 512, LDO = 2048;
constexpr size_t SHM_V = KVBLK * DH * 2, SHM_K = KVBLK * DH * 2;
#define KSWZ(row, colB) ((row) * 256 + ((colB) ^ (((row) & 7) << 4)))
#define SBAR() __builtin_amdgcn_sched_barrier(0)
__device__ __forceinline__ int crow(int r, int hi) { return (r & 3) + 8 * (r >> 2) + 4 * hi; }
__device__ __forceinline__ void partialSM(f32x16& p0, f32x16& p1, float& m_reg, float& mn, float& alpha) {
  constexpr float C = SCALE * 1.4426950408889634f;
  float pmax = p0[0];
#pragma unroll
  for (int r = 1; r < 16; ++r) pmax = fmaxf(pmax, p0[r]);
#pragma unroll
  for (int r = 0; r < 16; ++r) pmax = fmaxf(pmax, p1[r]);
  { auto rr = __builtin_amdgcn_permlane32_swap(__float_as_uint(pmax), __float_as_uint(pmax), false, false);
    pmax = fmaxf(__uint_as_float(rr[0]), __uint_as_float(rr[1])); }
  if (__builtin_expect(__all(pmax - m_reg <= THR / SCALE), 1)) { mn = m_reg; alpha = 1.f; }
  else { mn = fmaxf(m_reg, pmax); alpha = __builtin_amdgcn_exp2f((m_reg - mn) * C); m_reg = mn; }
  float mnC = -mn * C;
#pragma unroll
  for (int r = 0; r < 16; ++r) p0[r] = fmaf(p0[r], C, mnC);
#pragma unroll
  for (int r = 0; r < 16; ++r) p1[r] = fmaf(p1[r], C, mnC);
#pragma unroll
  for (int r = 0; r < 16; ++r) p0[r] = __builtin_amdgcn_exp2f(p0[r]);
}
__device__ __forceinline__ void finishSM(f32x16& p0, f32x16& p1, float alpha, float& l_reg, bf16x8& pa0, bf16x8& pa1, bf16x8& pa2, bf16x8& pa3) {
#pragma unroll
  for (int r = 0; r < 16; ++r) p1[r] = __builtin_amdgcn_exp2f(p1[r]);
  float ps = 0;
#pragma unroll
  for (int r = 0; r < 16; ++r) ps += p0[r];
#pragma unroll
  for (int r = 0; r < 16; ++r) ps += p1[r];
  { auto rr = __builtin_amdgcn_permlane32_swap(__float_as_uint(ps), __float_as_uint(ps), false, false);
    ps = __uint_as_float(rr[0]) + __uint_as_float(rr[1]); }
  l_reg = l_reg * alpha + ps;
#define PK4(P, BASE, OUT) do { unsigned a0 = cvt_pk_bf16(P[BASE + 0], P[BASE + 1]), a1 = cvt_pk_bf16(P[BASE + 2], P[BASE + 3]);   \
    unsigned b0 = cvt_pk_bf16(P[BASE + 4], P[BASE + 5]), b1 = cvt_pk_bf16(P[BASE + 6], P[BASE + 7]);                              \
    auto r0 = __builtin_amdgcn_permlane32_swap(a0, b0, false, false); auto r1 = __builtin_amdgcn_permlane32_swap(a1, b1, false, false); \
    u32x4 w = {r0[0], r1[0], r0[1], r1[1]}; OUT = *reinterpret_cast<bf16x8*>(&w); } while (0)
  PK4(p0, 0, pa0); PK4(p0, 8, pa1); PK4(p1, 0, pa2); PK4(p1, 8, pa3);
#undef PK4
}
__device__ __forceinline__ void qkt(f32x16& p0, f32x16& p1, const bf16_t* Ks, const bf16x8* qr, int r32, int hi) {
  p0 = f32x16{}; p1 = f32x16{};
#pragma unroll
  for (int d0 = 0; d0 < 8; ++d0) { int cb = (d0 * 16 + hi * 8) * 2;
    bf16x8 b0 = *reinterpret_cast<const bf16x8*>((const char*)Ks + KSWZ(r32, cb));
    bf16x8 b1 = *reinterpret_cast<const bf16x8*>((const char*)Ks + KSWZ(32 + r32, cb));
    p0 = __builtin_amdgcn_mfma_f32_32x32x16_bf16(b0, qr[d0], p0, 0, 0, 0);
    p1 = __builtin_amdgcn_mfma_f32_32x32x16_bf16(b1, qr[d0], p1, 0, 0, 0); }
}
__device__ __forceinline__ int v_st(int k, int c) { const int kk = (k & ~0xC) | ((k & 4) << 1) | ((k & 8) >> 1); return ((kk >> 3) * 4 + (c >> 5)) * 512 + ((kk & 7) * 32 + (c & 31)) * 2; }
__device__ __forceinline__ int v_rd_base(int lane) { return ((lane & 3) << 3) | (((lane >> 2) & 3) << 6) | (((lane >> 4) & 1) << 5) | (((lane >> 5) & 1) << 8); }
constexpr int v_rd_off(int d0, int ks, int half) { return d0 * 512 + ks * 4096 + half * 2048; }
template <int OFF> __device__ __forceinline__ s16x4 tr_read(int vb) {
  s16x4 r; asm volatile("ds_read_b64_tr_b16 %0, %1 offset:%2" : "=&v"(r) : "v"(vb), "i"(OFF) : "memory"); return r;
}
template <int D0> __device__ __forceinline__ void pv_one(f32x16& od, int vb, bf16x8 pa0, bf16x8 pa1, bf16x8 pa2, bf16x8 pa3) {
  const s16x4 l0 = tr_read<v_rd_off(D0, 0, 0)>(vb), h0 = tr_read<v_rd_off(D0, 0, 1)>(vb), l1 = tr_read<v_rd_off(D0, 1, 0)>(vb), h1 = tr_read<v_rd_off(D0, 1, 1)>(vb);
  const s16x4 l2 = tr_read<v_rd_off(D0, 2, 0)>(vb), h2 = tr_read<v_rd_off(D0, 2, 1)>(vb), l3 = tr_read<v_rd_off(D0, 3, 0)>(vb), h3 = tr_read<v_rd_off(D0, 3, 1)>(vb);
  asm volatile("s_waitcnt lgkmcnt(0)" ::: "memory"); SBAR();
#define PK(L, H) (bf16x8){L[0], L[1], L[2], L[3], H[0], H[1], H[2], H[3]}
  od = __builtin_amdgcn_mfma_f32_32x32x16_bf16(pa0, PK(l0, h0), od, 0, 0, 0);
  od = __builtin_amdgcn_mfma_f32_32x32x16_bf16(pa1, PK(l1, h1), od, 0, 0, 0);
  od = __builtin_amdgcn_mfma_f32_32x32x16_bf16(pa2, PK(l2, h2), od, 0, 0, 0);
  od = __builtin_amdgcn_mfma_f32_32x32x16_bf16(pa3, PK(l3, h3), od, 0, 0, 0);
#undef PK
}
__device__ __forceinline__ void pv_d0(f32x16* o, int vb, bf16x8 pa0, bf16x8 pa1, bf16x8 pa2, bf16x8 pa3) {
  pv_one<0>(o[0], vb, pa0, pa1, pa2, pa3); pv_one<1>(o[1], vb, pa0, pa1, pa2, pa3); pv_one<2>(o[2], vb, pa0, pa1, pa2, pa3); pv_one<3>(o[3], vb, pa0, pa1, pa2, pa3);
}
__device__ __forceinline__ void attn_dense_body(const bf16_t* __restrict__ Qb, const bf16_t* __restrict__ Kh, const bf16_t* __restrict__ Vh,
                                                unsigned char* __restrict__ Ob, int seq, char* lds, LAS unsigned char* lds3, const int wave_) {
  const int wid = wave_, lane = lane_id_(), tid = wid * 64 + lane, r32 = lane & 31, hi = lane >> 5;
  bf16_t* V_lds = (bf16_t*)lds; bf16_t* K_lds = (bf16_t*)(lds + 2 * SHM_V);
  float* ws = (float*)(lds + 2 * SHM_V + 2 * SHM_K) + wid * 64; float* li_l = ws; float* al_l = ws + 32;
  float m_reg = -1e30f, l_reg = 0; f32x16 o[4] = {}; bf16x8 qr[8];
  const bf16_t* Qw = Qb + (long)(wid * QBLK + r32) * LDQ + hi * 8;
#pragma unroll
  for (int d0 = 0; d0 < 8; ++d0) qr[d0] = *reinterpret_cast<const bf16x8*>(Qw + d0 * 16);
  const int sr = tid >> 4, sc = (tid & 15) * 8, vst0 = v_st(sr, sc), vst1 = v_st(32 + sr, sc);
  const int vb0 = (int)(uintptr_t)V_lds + v_rd_base(lane);
  struct { bf16x8 vs0, vs1, ks0, ks1; } sr_[2];
#define SLOAD(i, k0) do { sr_[i].vs0 = *reinterpret_cast<const bf16x8*>(&Vh[(long)((k0) + sr) * LDK + sc]); sr_[i].vs1 = *reinterpret_cast<const bf16x8*>(&Vh[(long)((k0) + 32 + sr) * LDK + sc]); \
    sr_[i].ks0 = *reinterpret_cast<const bf16x8*>(&Kh[(long)((k0) + sr) * LDK + sc]); sr_[i].ks1 = *reinterpret_cast<const bf16x8*>(&Kh[(long)((k0) + 32 + sr) * LDK + sc]); } while (0)
#define SWRITE(b, i) do { *(bf16x8*)((char*)V_lds + (b) * SHM_V + vst0) = sr_[i].vs0;          \
    *(bf16x8*)((char*)V_lds + (b) * SHM_V + vst1) = sr_[i].vs1; int kc = sc * 2;               \
    *(bf16x8*)((char*)K_lds + (b) * SHM_K + KSWZ(sr, kc)) = sr_[i].ks0;                       \
    *(bf16x8*)((char*)K_lds + (b) * SHM_K + KSWZ(32 + sr, kc)) = sr_[i].ks1; } while (0)
#define SWAIT() do { asm volatile("s_waitcnt vmcnt(4)" ::: "memory"); } while (0)
#define RESC(a) do { if (__any((a) < 1.f)) { if (hi == 0) al_l[r32] = (a); asm volatile("s_waitcnt lgkmcnt(0)" ::: "memory"); \
    _Pragma("unroll") for (int d = 0; d < 4; ++d) _Pragma("unroll") for (int r = 0; r < 16; ++r) o[d][r] *= al_l[crow(r, hi)]; } } while (0)
  f32x16 pA0, pA1, pB0, pB1; float mnA, mnB, alA, alB; bf16x8 pa0, pa1, pa2, pa3; const int NT = seq / KVBLK;
  constexpr int SE = 0, SO = 1;
  SLOAD(SE, 0); asm volatile("s_waitcnt vmcnt(0)" ::: "memory"); SWRITE(0, SE); __syncthreads();
  qkt(pA0, pA1, K_lds, qr, r32, hi); partialSM(pA0, pA1, m_reg, mnA, alA);
  SLOAD(SO, KVBLK); if (2 < NT) SLOAD(SE, 2 * KVBLK);
  SWAIT(); SWRITE(1, SO); __syncthreads();
  for (int j = 1; j + 1 < NT; j += 2) {
    SBAR(); qkt(pB0, pB1, (bf16_t*)((char*)K_lds + SHM_K), qr, r32, hi);
    finishSM(pA0, pA1, alA, l_reg, pa0, pa1, pa2, pa3); SBAR();
    SLOAD(SO, (j + 2) * KVBLK); SBAR();
    pv_d0(o, vb0, pa0, pa1, pa2, pa3); partialSM(pB0, pB1, m_reg, mnB, alB);
    __syncthreads(); SWAIT(); SWRITE(0, SE);
    RESC(alB); __syncthreads();
    SBAR(); qkt(pA0, pA1, K_lds, qr, r32, hi);
    finishSM(pB0, pB1, alB, l_reg, pa0, pa1, pa2, pa3); SBAR();
    if (j + 3 < NT) SLOAD(SE, (j + 3) * KVBLK); SBAR();
    pv_d0(o, vb0 + (int)SHM_V, pa0, pa1, pa2, pa3); partialSM(pA0, pA1, m_reg, mnA, alA);
    __syncthreads(); SWAIT(); SWRITE(1, SO);
    RESC(alA); __syncthreads();
  }
  SBAR(); qkt(pB0, pB1, (bf16_t*)((char*)K_lds + SHM_K), qr, r32, hi);
  finishSM(pA0, pA1, alA, l_reg, pa0, pa1, pa2, pa3); SBAR();
  pv_d0(o, vb0, pa0, pa1, pa2, pa3); partialSM(pB0, pB1, m_reg, mnB, alB);
  __syncthreads(); RESC(alB);
  finishSM(pB0, pB1, alB, l_reg, pa0, pa1, pa2, pa3); SBAR();
  pv_d0(o, vb0 + (int)SHM_V, pa0, pa1, pa2, pa3);
  if (hi == 0) li_l[r32] = l_reg; asm volatile("s_waitcnt lgkmcnt(0)" ::: "memory");
  float rli[16];
#pragma unroll
  for (int r = 0; r < 16; ++r) rli[r] = __builtin_amdgcn_rcpf(li_l[crow(r, hi)]);
  LAS unsigned char* stg = lds3 + 68 * 1024 + wid * 8192;
#pragma unroll
  for (int r = 0; r < 16; ++r) { const int orow = crow(r, hi);
#pragma unroll
    for (int d0 = 0; d0 < 4; ++d0) *(LAS unsigned short*)(stg + orow * 256 + (d0 * 32 + r32) * 2) = (unsigned short)(cvt_pk_bf16(o[d0][r] * rli[r], 0.f) & 0xffffu); }
  unsigned char* Ow = Ob + (long)(wid * QBLK) * LDO;
#pragma unroll
  for (int j = 0; j < 4; ++j) {
    const int idx = lane + 64 * j, orow = idx >> 3, ch = idx & 7;
    const u32x4 a = *(const LAS u32x4*)(stg + orow * 256 + ch * 32), b = *(const LAS u32x4*)(stg + orow * 256 + ch * 32 + 16);
    u32x4 w;
    w.x = pk4_fp8(bf_lo(a.x) * AO_SCALE, bf_hi(a.x) * AO_SCALE, bf_lo(a.y) * AO_SCALE, bf_hi(a.y) * AO_SCALE); w.y = pk4_fp8(bf_lo(a.z) * AO_SCALE, bf_hi(a.z) * AO_SCALE, bf_lo(a.w) * AO_SCALE, bf_hi(a.w) * AO_SCALE);
    w.z = pk4_fp8(bf_lo(b.x) * AO_SCALE, bf_hi(b.x) * AO_SCALE, bf_lo(b.y) * AO_SCALE, bf_hi(b.y) * AO_SCALE); w.w = pk4_fp8(bf_lo(b.z) * AO_SCALE, bf_hi(b.z) * AO_SCALE, bf_lo(b.w) * AO_SCALE, bf_hi(b.w) * AO_SCALE);
    *(u32x4*)(Ow + (long)orow * LDO + ch * 16) = w;
  }
  __syncthreads();
#undef SLOAD
#undef SWRITE
#undef SWAIT
#undef RESC
}
}

namespace ml {
constexpr int QS = 0, KS = 33792, VS = 67584, VWS = 76800, SS = 86016, CTS = 95232, NV = 129024;
constexpr int SC_A = 130048, SC_M = SC_A + 256, SC_WI = SC_M + 256, SC_TH = SC_WI + 256, SC_WS = SC_TH + 256, SC_DEN = SC_WS + 256, SC_WC = SC_DEN + 256, NV2 = SC_WC + 256;
constexpr int RQ = 528, RV = 144;

__device__ __forceinline__ bf16x8 tr_pair(const LAS unsigned char* p, int rowstride4) {
    const s16x4 lo = __builtin_amdgcn_ds_read_tr16_b64_v4i16((LAS s16x4*)p);
    const s16x4 hi = __builtin_amdgcn_ds_read_tr16_b64_v4i16((LAS s16x4*)(p + rowstride4));
    return (bf16x8){lo[0], lo[1], lo[2], lo[3], hi[0], hi[1], hi[2], hi[3]};
}

struct Conv { const float* w_gu; const float* w_dn; unsigned char* WTGU; unsigned char* WTDN; int t, nw; };
constexpr int T_GU = NE * 16 * 128, T_DN = NE * 16 * 64, T_CONV = T_GU + T_DN;
#define CV_ISSUE() do { if (cvs.t < T_CONV) { const float* sp_; \
        if (cvs.t < T_GU) { const int e_ = cvs.t >> 11, r_ = cvs.t & 2047, nb_ = r_ & 127, kb_ = r_ >> 7; sp_ = cvs.w_gu + (size_t)e_ * 2048 * 4096 + (size_t)(kb_ * 128 + (lane >> 3) * 16) * 4096 + nb_ * 32 + (lane & 7) * 4; \
            _Pragma("unroll") for (int kk = 0; kk < 16; ++kk) cv[kk] = __builtin_nontemporal_load((const f32x4*)(sp_ + (size_t)kk * 4096)); } \
        else { const int q_ = cvs.t - T_GU, e_ = q_ >> 10, r_ = q_ & 1023, nb_ = r_ & 63, kb_ = r_ >> 6; sp_ = cvs.w_dn + (size_t)e_ * 2048 * 2048 + (size_t)(kb_ * 128 + (lane >> 3) * 16) * 2048 + nb_ * 32 + (lane & 7) * 4; \
            _Pragma("unroll") for (int kk = 0; kk < 16; ++kk) cv[kk] = __builtin_nontemporal_load((const f32x4*)(sp_ + (size_t)kk * 2048)); } } } while (0)
#define CV_FINISH() do { if (cvs.t < T_CONV) { unsigned char* dp_; \
        if (cvs.t < T_GU) { const int e_ = cvs.t >> 11, r_ = cvs.t & 2047, nb_ = r_ & 127, kb_ = r_ >> 7, n_ = nb_ * 32 + (lane & 7) * 4, j_ = n_ & 2047, nd_ = (j_ >> 7) * 256 + ((n_ >> 11) << 7) + (j_ & 127); \
            dp_ = cvs.WTGU + ((size_t)e_ * 4096 + nd_) * D + kb_ * 128 + (lane >> 3) * 16; } \
        else { const int q_ = cvs.t - T_GU, e_ = q_ >> 10, r_ = q_ & 1023, nb_ = r_ & 63, kb_ = r_ >> 6, n_ = nb_ * 32 + (lane & 7) * 4; \
            dp_ = cvs.WTDN + ((size_t)e_ * 2048 + n_) * D + kb_ * 128 + (lane >> 3) * 16; } \
        _Pragma("unroll") for (int j = 0; j < 4; ++j) { u32x4 w_; \
            w_.x = pk4_fp8(cv[0][j] * WSCALE, cv[1][j] * WSCALE, cv[2][j] * WSCALE, cv[3][j] * WSCALE); \
            w_.y = pk4_fp8(cv[4][j] * WSCALE, cv[5][j] * WSCALE, cv[6][j] * WSCALE, cv[7][j] * WSCALE); \
            w_.z = pk4_fp8(cv[8][j] * WSCALE, cv[9][j] * WSCALE, cv[10][j] * WSCALE, cv[11][j] * WSCALE); \
            w_.w = pk4_fp8(cv[12][j] * WSCALE, cv[13][j] * WSCALE, cv[14][j] * WSCALE, cv[15][j] * WSCALE); \
            *(u32x4*)(dp_ + (size_t)j * D) = w_; } } cvs.t += cvs.nw; } while (0)

__device__ __forceinline__ void mlstm_unit(LAS unsigned char* lds, const bf16_t* __restrict__ PM, const float* __restrict__ GATES, bf16_t* __restrict__ Hout,
                                           int b, int h, int dir, int vs, Conv& cvs, const int wave_) {
    f32x4 cv[16];
    const int w = wave_, lane = lane_id_(), tid = w * 64 + lane, g = lane >> 4, i16 = lane & 15, q4 = i16 >> 2, p4 = lane & 3;
    const int sr = tid >> 3, c8 = tid & 7;
    f32x4 accC[2][4];
#pragma unroll
    for (int a = 0; a < 2; ++a)
#pragma unroll
        for (int v = 0; v < 4; ++v) accC[a][v] = (f32x4){0.f, 0.f, 0.f, 0.f};
    if (tid < 256) *(LAS float*)(lds + NV + tid * 4) = 0.f;
    float m_in = 0.f;
    bool pend_b = false;
    u32x4 rq[4], rk[4], rv; float g_i = 0.f, g_f = 0.f;
    const int gi_col = (dir ? 8 : 0) + h, gf_col = (dir ? 12 : 4) + h;
#define ML_ROW0(ci) ((ci) < 4 ? (NLAT + b * NCTXB + (dir ? (NCTXB - 64 * ((ci) + 1)) : 64 * (ci))) : (b * TSEQ + (dir ? (TSEQ - 64 * ((ci) - 3)) : 64 * ((ci) - 4))))
#define ML_LOAD(ci) do { const int _r0 = ML_ROW0(ci); const bf16_t* _rp = PM + (size_t)(_r0 + sr) * 6144; \
        _Pragma("unroll") for (int j = 0; j < 4; ++j) rk[j] = *(const u32x4*)(_rp + 1024 + h * 256 + (j * 8 + c8) * 8); \
        rv = *(const u32x4*)(_rp + 2048 + h * 512 + vs * 64 + c8 * 8); \
        if ((ci) >= 4) { _Pragma("unroll") for (int j = 0; j < 4; ++j) rq[j] = *(const u32x4*)(_rp + h * 256 + (j * 8 + c8) * 8); } \
        if (w == 0) { const int _p = dir ? 63 - lane : lane; g_i = GATES[(size_t)(_r0 + _p) * 16 + gi_col]; g_f = GATES[(size_t)(_r0 + _p) * 16 + gf_col]; } } while (0)
    ML_LOAD(0);
#pragma unroll 1
    for (int ci = 0; ci < 36; ++ci) {
        const bool lat = ci >= 4;
        const int row0 = ML_ROW0(ci);
#pragma unroll
        for (int j = 0; j < 4; ++j) *(LAS u32x4*)(lds + KS + sr * RQ + (j * 8 + c8) * 16) = rk[j];
        *(LAS u32x4*)(lds + VS + sr * RV + c8 * 16) = rv;
        if (lat) {
#pragma unroll
            for (int j = 0; j < 4; ++j) *(LAS u32x4*)(lds + QS + sr * RQ + (j * 8 + c8) * 16) = rq[j];
        }
        if (w == 0) {
            const float lf = fminf(g_f, 0.f) - __logf(1.f + __expf(-fabsf(g_f)));
            const float bc = wave_scan_add(lf);
            const float a = g_i - bc;
            const float pm = wave_scan_max(a);
            const float M = fmaxf(m_in, pm);
            const float M63 = __int_as_float(__builtin_amdgcn_readlane(__float_as_int(M), 63)), b63 = __int_as_float(__builtin_amdgcn_readlane(__float_as_int(bc), 63));
            const int p = dir ? 63 - lane : lane;
            *(LAS float*)(lds + SC_A + p * 4) = a;
            *(LAS float*)(lds + SC_M + p * 4) = M;
            *(LAS float*)(lds + SC_WI + p * 4) = __expf(m_in - M);
            *(LAS float*)(lds + SC_TH + p * 4) = __expf(-(bc + M));
            *(LAS float*)(lds + SC_WS + p * 4) = __expf(a - M63);
            if (lane == 0) *(LAS float*)(lds + SC_WC) = __expf(m_in - M63);
            m_in = b63 + M63;
        }
        __syncthreads();
        if (ci > 0 && tid < 256) *(LAS float*)(lds + NV + tid * 4) += *(LAS float*)(lds + NV2 + tid * 4);
        {
            const float wsv = *(LAS float*)(lds + SC_WS + sr * 4);
            u32x4 o;
            o.x = cvt_pk_bf16(bf_lo(rv.x) * wsv, bf_hi(rv.x) * wsv); o.y = cvt_pk_bf16(bf_lo(rv.y) * wsv, bf_hi(rv.y) * wsv);
            o.z = cvt_pk_bf16(bf_lo(rv.z) * wsv, bf_hi(rv.z) * wsv); o.w = cvt_pk_bf16(bf_lo(rv.w) * wsv, bf_hi(rv.w) * wsv);
            *(LAS u32x4*)(lds + VWS + sr * RV + c8 * 16) = o;
        }
        if (pend_b) { CV_FINISH(); pend_b = false; }
        if (ci + 1 < 36) ML_LOAD(ci + 1);
        CV_ISSUE();
        const int tb0 = 2 * (w >> 2);
        if (lat) {
            const int s0 = 16 * (w & 3);
            f32x4 accS[2] = {(f32x4){0.f, 0.f, 0.f, 0.f}, (f32x4){0.f, 0.f, 0.f, 0.f}};
#pragma unroll 2
            for (int ks = 0; ks < 8; ++ks) {
                const bf16x8 A = *(const LAS bf16x8*)(lds + KS + (s0 + i16) * RQ + (32 * ks + 8 * g) * 2);
#pragma unroll
                for (int tb = 0; tb < 2; ++tb) {
                    const bf16x8 B = *(const LAS bf16x8*)(lds + QS + (16 * (tb0 + tb) + i16) * RQ + (32 * ks + 8 * g) * 2);
                    accS[tb] = __builtin_amdgcn_mfma_f32_16x16x32_bf16(A, B, accS[tb], 0, 0, 0);
                }
            }
#pragma unroll
            for (int tb = 0; tb < 2; ++tb) {
                const int tp = 16 * (tb0 + tb) + i16;
                const float Mt = *(LAS float*)(lds + SC_M + tp * 4);
                float v[4];
#pragma unroll
                for (int r = 0; r < 4; ++r) {
                    const int sp = s0 + 4 * g + r;
                    const bool ok = dir ? (sp >= tp) : (sp <= tp);
                    const float as = *(LAS float*)(lds + SC_A + sp * 4);
                    v[r] = ok ? accS[tb][r] * __expf(as - Mt) : 0.f;
                }
                u32x2 o; o.x = cvt_pk_bf16(v[0], v[1]); o.y = cvt_pk_bf16(v[2], v[3]);
                *(LAS u32x2*)(lds + SS + tp * RV + (s0 + 4 * g) * 2) = o;
            }
        }
        __syncthreads();
        f32x4 accO[2] = {(f32x4){0.f, 0.f, 0.f, 0.f}, (f32x4){0.f, 0.f, 0.f, 0.f}};
        const int v0 = 16 * (w & 3);
        if (lat) {
            {
                const int t = sr, part = c8;
                const u32x4 sv = *(const LAS u32x4*)(lds + SS + t * RV + part * 16);
                float rs = bf_lo(sv.x) + bf_hi(sv.x) + bf_lo(sv.y) + bf_hi(sv.y) + bf_lo(sv.z) + bf_hi(sv.z) + bf_lo(sv.w) + bf_hi(sv.w);
                float qn = 0.f;
#pragma unroll
                for (int j = 0; j < 4; ++j) {
                    const u32x4 qv = *(const LAS u32x4*)(lds + QS + t * RQ + part * 64 + j * 16);
                    const f32x4 n0 = *(const LAS f32x4*)(lds + NV + (part * 32 + j * 8) * 4), n1 = *(const LAS f32x4*)(lds + NV + (part * 32 + j * 8 + 4) * 4);
                    qn += bf_lo(qv.x) * n0[0] + bf_hi(qv.x) * n0[1] + bf_lo(qv.y) * n0[2] + bf_hi(qv.y) * n0[3]
                        + bf_lo(qv.z) * n1[0] + bf_hi(qv.z) * n1[1] + bf_lo(qv.w) * n1[2] + bf_hi(qv.w) * n1[3];
                }
                rs = sum8_dpp(rs); qn = sum8_dpp(qn);
                if (part == 0) {
                    const float den = rs + *(LAS float*)(lds + SC_WI + t * 4) * qn;
                    *(LAS float*)(lds + SC_DEN + t * 4) = 1.f / fmaxf(fabsf(den), *(LAS float*)(lds + SC_TH + t * 4));
                }
            }
#pragma unroll 2
            for (int ks = 0; ks < 8; ++ks) {
                const bf16x8 A = *(const LAS bf16x8*)(lds + CTS + (v0 + i16) * RQ + (32 * ks + 8 * g) * 2);
#pragma unroll
                for (int tb = 0; tb < 2; ++tb) {
                    const bf16x8 B = *(const LAS bf16x8*)(lds + QS + (16 * (tb0 + tb) + i16) * RQ + (32 * ks + 8 * g) * 2);
                    accO[tb] = __builtin_amdgcn_mfma_f32_16x16x32_bf16(A, B, accO[tb], 0, 0, 0);
                }
            }
#pragma unroll
            for (int tb = 0; tb < 2; ++tb) accO[tb] *= *(LAS float*)(lds + SC_WI + (16 * (tb0 + tb) + i16) * 4);
#pragma unroll
            for (int s2 = 0; s2 < 2; ++s2) {
                const bf16x8 A = tr_pair(lds + VS + (32 * s2 + 8 * g + q4) * RV + (v0 + 4 * p4) * 2, 4 * RV);
#pragma unroll
                for (int tb = 0; tb < 2; ++tb) {
                    const bf16x8 B = *(const LAS bf16x8*)(lds + SS + (16 * (tb0 + tb) + i16) * RV + (32 * s2 + 8 * g) * 2);
                    accO[tb] = __builtin_amdgcn_mfma_f32_16x16x32_bf16(A, B, accO[tb], 0, 0, 0);
                }
            }
        }
        __syncthreads();
        if (lat) {
#pragma unroll
            for (int tb = 0; tb < 2; ++tb) {
                const int tp = 16 * (tb0 + tb) + i16;
                const float rd = *(LAS float*)(lds + SC_DEN + tp * 4);
                u32x2 o; o.x = cvt_pk_bf16(accO[tb][0] * rd, accO[tb][1] * rd); o.y = cvt_pk_bf16(accO[tb][2] * rd, accO[tb][3] * rd);
                *(u32x2*)(Hout + (size_t)(row0 + tp) * 2048 + h * 512 + vs * 64 + v0 + 4 * g) = o;
            }
        }
        CV_FINISH();
        if ((ci % 3) == 0) { CV_ISSUE(); pend_b = true; }
        {
            const float wcv = *(LAS float*)(lds + SC_WC);
            const int k0 = 32 * w;
#pragma unroll
            for (int a = 0; a < 2; ++a)
#pragma unroll
                for (int v = 0; v < 4; ++v) accC[a][v] *= wcv;
#pragma unroll
            for (int s2 = 0; s2 < 2; ++s2) {
                bf16x8 A[2], B[4];
#pragma unroll
                for (int a = 0; a < 2; ++a) A[a] = tr_pair(lds + KS + (32 * s2 + 8 * g + q4) * RQ + (k0 + 16 * a + 4 * p4) * 2, 4 * RQ);
#pragma unroll
                for (int v = 0; v < 4; ++v) B[v] = tr_pair(lds + VWS + (32 * s2 + 8 * g + q4) * RV + (16 * v + 4 * p4) * 2, 4 * RV);
#pragma unroll
                for (int a = 0; a < 2; ++a)
#pragma unroll
                    for (int v = 0; v < 4; ++v) accC[a][v] = __builtin_amdgcn_mfma_f32_16x16x32_bf16(A[a], B[v], accC[a][v], 0, 0, 0);
            }
#pragma unroll
            for (int a = 0; a < 2; ++a)
#pragma unroll
                for (int v = 0; v < 4; ++v) {
                    u32x2 o; o.x = cvt_pk_bf16(accC[a][v][0], accC[a][v][1]); o.y = cvt_pk_bf16(accC[a][v][2], accC[a][v][3]);
                    *(LAS u32x2*)(lds + CTS + (16 * v + i16) * RQ + (k0 + 16 * a + 4 * g) * 2) = o;
                }
            {
                const int kk_ = tid & 255, hf_ = tid >> 8;
                float nv = hf_ ? 0.f : wcv * *(LAS float*)(lds + NV + kk_ * 4);
#pragma unroll 8
                for (int s = 0; s < 32; ++s) nv += *(LAS float*)(lds + SC_WS + (hf_ * 32 + s) * 4) * bf_s(*(const LAS unsigned short*)(lds + KS + (hf_ * 32 + s) * RQ + kk_ * 2));
                *(LAS float*)(lds + (hf_ ? NV2 : NV) + kk_ * 4) = nv;
            }
        }
        __syncthreads();
    }
    if (pend_b) CV_FINISH();
#undef ML_ROW0
#undef ML_LOAD
}
}

__global__ void __launch_bounds__(NTHREADS, 2) fwd(Args args) {
    extern __shared__ __attribute__((aligned(16))) unsigned char lds_raw[];
    LAS unsigned char* lds = (LAS unsigned char*)lds_raw;
    volatile LAS unsigned* MISC = (volatile LAS unsigned*)(lds + MISC_OFF);
    const int wave = __builtin_amdgcn_readfirstlane((int)threadIdx.x >> 6);
    const int G = gridDim.x, bx = blockIdx.x;
    const int vcu = (G % 8 == 0) ? (bx % 8) * (G / 8) + bx / 8 : bx;
    unsigned char* ws = args.ws;
    unsigned* ctl = (unsigned*)(ws + WS_CTL);
    { const int tid0 = wave * 64 + lane_id_(); for (int u = tid0; u < 256; u += NTHREADS) MISC[u] = 0u; }
    __syncthreads();
    XcdBarrier bar = xcd_barrier_post(ctl + CW_BAR, MISC, wave == 0 && lane_id_() == 0);
    const int lo = args.ph_lo, hi = args.ph_hi;
#define IN(k) (lo <= (k) && (k) < hi)
#define NREP(k) (1 + ((REP_MASK >> (k)) & 1))
#define SEAM(k) do { if (IN(k) && IN((k) + 1)) xcd_barrier(bar, wave); } while (0)

    const float* x = args.in[0]; const float* cvec = args.in[1]; const float* ctx = args.in[2]; const float* c_ctx = args.in[3];
    const float* w_mod = args.in[4]; const float* b_mod = args.in[5]; const float* g_norm1 = args.in[6]; const float* g_norm2 = args.in[7];
    const float* w_in = args.in[8]; const float* b_in = args.in[9]; const float* g_q = args.in[10]; const float* g_k = args.in[11]; const float* g_mh = args.in[12];
    const float* w_br_m = args.in[13]; const float* w_br_a = args.in[14]; const float* w_out = args.in[15];
    const float* w_router = args.in[16]; const float* b_router = args.in[17]; const float* w_gu = args.in[18]; const float* b_gu = args.in[19];
    const float* w_dn = args.in[20]; const float* b_dn = args.in[21];
    float* out = args.out;
    float* MOD = (float*)(ws + WS_MOD); float* BINP = (float*)(ws + WS_BINP);
    bf16_t* WTIN = (bf16_t*)(ws + WS_WTIN); bf16_t* WTBRM = (bf16_t*)(ws + WS_WTBRM); bf16_t* WTBRA = (bf16_t*)(ws + WS_WTBRA); bf16_t* WTOUT = (bf16_t*)(ws + WS_WTOUT);
    unsigned char* WTGU = ws + WS_WTGU; unsigned char* WTDN = ws + WS_WTDN;
    bf16_t* U = (bf16_t*)(ws + WS_U); bf16_t* PM = (bf16_t*)(ws + WS_PM); float* GATES = (float*)(ws + WS_GATES);
    unsigned char* OG8 = ws + WS_AQ;        bf16_t* AK = (bf16_t*)(ws + WS_AK); bf16_t* VV = (bf16_t*)(ws + WS_VV); bf16_t* KR = (bf16_t*)(ws + WS_KR); bf16_t* QR = (bf16_t*)(ws + WS_QR);
    unsigned char* MG = ws + WS_MG; bf16_t* AO = (bf16_t*)(ws + WS_AO); bf16_t* HF = (bf16_t*)(ws + WS_HF); bf16_t* HB = (bf16_t*)(ws + WS_HB);
    bf16_t* MX = (bf16_t*)(ws + WS_MX); bf16_t* MRG = (bf16_t*)(ws + WS_MRG); unsigned char* U2 = ws + WS_U2;
    int* TOPE = (int*)(ws + WS_TOPE); int* TOPP = (int*)(ws + WS_TOPP); float* TOPW = (float*)(ws + WS_TOPW); int* LIST = (int*)(ws + WS_LIST);
    unsigned char* HID = ws + WS_HID; bf16_t* Y = (bf16_t*)(ws + WS_Y); unsigned char* WTIN8 = ws + WS_WTIN8; unsigned char* U8 = ws + WS_U8;
    unsigned char* W8BRM = ws + WS_W8BRM; unsigned char* W8BRA = ws + WS_W8BRA; unsigned char* W8OUT = ws + WS_W8OUT; unsigned char* MX8 = ws + WS_MX8; unsigned char* AO8 = ws + WS_AO8; unsigned char* MRG8 = ws + WS_MRG8; float* ROPE = (float*)(ws + WS_ROPE); bf16_t* HX1 = (bf16_t*)(ws + WS_HX1);
    unsigned* ECNT = ctl + CW_CNT;

    if (IN(0)) {
        const int lane = lane_id_(), tid = wave * 64 + lane; (void)tid; (void)lane;
_Pragma("unroll")
    for (int rep_ = 0; rep_ < NREP(0); ++rep_) { if (rep_) xcd_barrier(bar, wave);
        if (bx < 192) {
            LAS float* sc = (LAS float*)lds;
            LAS float* red = (LAS float*)(lds + 5 * 2048 * 4);
            for (int idx = tid; idx < 5 * 2048; idx += NTHREADS) { const int r = idx >> 11, k = idx & 2047; const float v = (r < 4) ? cvec[r * 2048 + k] : c_ctx[k]; sc[idx] = v / (1.f + __expf(-v)); }
            __syncthreads();
            const int cq = lane & 15, kr = lane >> 4;
            f32x4 ac[5];
#pragma unroll
            for (int r = 0; r < 5; ++r) ac[r] = (f32x4){0.f, 0.f, 0.f, 0.f};
            const float* wp = w_mod + (size_t)(wave * 256 + kr) * 12288 + bx * 64 + cq * 4;
#pragma unroll 8
            for (int kk = 0; kk < 64; ++kk) {
                const f32x4 wv = *(const f32x4*)(wp + (size_t)kk * 4 * 12288); const int k = wave * 256 + kk * 4 + kr;
#pragma unroll
                for (int r = 0; r < 5; ++r) ac[r] += wv * sc[r * 2048 + k];
            }
#pragma unroll
            for (int r = 0; r < 5; ++r) {
#pragma unroll
                for (int j = 0; j < 4; ++j) {
                    float v = ac[r][j];
                    { auto r_ = __builtin_amdgcn_permlane16_swap(__float_as_uint(v), __float_as_uint(v), false, false); v = __uint_as_float(r_[0]) + __uint_as_float(r_[1]); }
                    { auto r_ = __builtin_amdgcn_permlane32_swap(__float_as_uint(v), __float_as_uint(v), false, false); v = __uint_as_float(r_[0]) + __uint_as_float(r_[1]); }
                    ac[r][j] = v;
                }
                if (kr == 0) *(LAS f32x4*)(red + (wave * 5 + r) * 64 + cq * 4) = ac[r];
            }
            __syncthreads();
            if (tid < 320) { const int r = tid >> 6, l = tid & 63; float s = 0.f;
#pragma unroll
                for (int ww = 0; ww < 8; ++ww) s += red[(ww * 5 + r) * 64 + l];
                MOD[r * 12288 + bx * 64 + l] = s + b_mod[bx * 64 + l]; }
            __syncthreads();
        }
        const int gtid = bx * NTHREADS + tid, gthreads = G * NTHREADS;
        for (int n = gtid; n < NP; n += gthreads) {
            float v = 0.f;
            if (n < 6144) v = b_in[n]; else if (n < 13312) v = b_in[n + 16]; else if (n < 13328) v = b_in[6144 + (n - 13312)];
            BINP[n] = v;
        }
        for (int idx = gtid; idx < (NP - F_IN) * (D / 8); idx += gthreads) *(u32x4*)(WTIN + (size_t)F_IN * D + (size_t)idx * 8) = (u32x4){0u, 0u, 0u, 0u};
        {
            const int nq = lane & 7, ks = lane >> 3;
            constexpr int T_IN = 16 * 417, T_SQ = 16 * 64;
            constexpr int T_ALL = T_IN + 3 * T_SQ;
            const bool wt = (G == 256);
            const int nw = wt ? 2560 : G * 8, nstream = (wt && bx >= 192) ? 2 : 1;
#pragma unroll 1
            for (int vs_ = 0; vs_ < nstream; ++vs_) {
            const int gw = !wt ? bx * 8 + wave : (bx < 192 ? bx * 8 + wave : 1536 + ((bx - 192) * 8 + wave) * 2 + vs_);
#pragma unroll 1
            for (int t = gw; t < T_ALL; t += nw) {
                const float* src; int N, nb, kb, mode; unsigned char* dstb; bool f8;
                if (t < T_IN) { nb = t % 417; kb = t / 417; src = w_in; N = F_IN; dstb = (unsigned char*)WTIN; mode = 1; f8 = false; }
                else { const int q = t - T_IN, mtx = q / T_SQ, r = q % T_SQ; nb = r & 63; kb = r >> 6; N = 2048; mode = 0; f8 = true;
                    src = mtx == 0 ? w_br_m : (mtx == 1 ? w_br_a : w_out); dstb = mtx == 0 ? W8BRM : (mtx == 1 ? W8BRA : W8OUT); }
                const int n = nb * 32 + nq * 4;
                if (n < N) {
                    const float* sp = src + (size_t)(kb * 128 + ks * 16) * N + n;
                    f32x4 v[16];
#pragma unroll
                    for (int kk = 0; kk < 16; ++kk) v[kk] = *(const f32x4*)(sp + (size_t)kk * N);
                    int nd = n;
                    if (mode == 1) nd = n < 6144 ? n : (n < 6160 ? 13312 + (n - 6144) : n - 16);
                    if (mode == 2) { const int j = n & 2047; nd = (j >> 7) * 256 + ((n >> 11) << 7) + (j & 127); }
                    bool f8l = f8;
                    if (mode == 1 && nd >= 2048 && nd < 13312) { f8l = true; nd -= 2048; dstb = WTIN8; }
                    if (f8l) {
                        unsigned char* dp = dstb + (size_t)nd * D + kb * 128 + ks * 16;
#pragma unroll
                        for (int j = 0; j < 4; ++j) {
                            u32x4 w;
                            w.x = pk4_fp8(v[0][j] * WSCALE, v[1][j] * WSCALE, v[2][j] * WSCALE, v[3][j] * WSCALE);
                            w.y = pk4_fp8(v[4][j] * WSCALE, v[5][j] * WSCALE, v[6][j] * WSCALE, v[7][j] * WSCALE);
                            w.z = pk4_fp8(v[8][j] * WSCALE, v[9][j] * WSCALE, v[10][j] * WSCALE, v[11][j] * WSCALE);
                            w.w = pk4_fp8(v[12][j] * WSCALE, v[13][j] * WSCALE, v[14][j] * WSCALE, v[15][j] * WSCALE);
                            *(u32x4*)(dp + (size_t)j * D) = w;
                        }
                    } else {
                        unsigned char* dp = dstb + ((size_t)nd * D + kb * 128 + ks * 16) * 2;
#pragma unroll
                        for (int j = 0; j < 4; ++j) {
                            u32x4 w0, w1;
                            w0.x = cvt_pk_bf16(v[0][j], v[1][j]); w0.y = cvt_pk_bf16(v[2][j], v[3][j]); w0.z = cvt_pk_bf16(v[4][j], v[5][j]); w0.w = cvt_pk_bf16(v[6][j], v[7][j]);
                            w1.x = cvt_pk_bf16(v[8][j], v[9][j]); w1.y = cvt_pk_bf16(v[10][j], v[11][j]); w1.z = cvt_pk_bf16(v[12][j], v[13][j]); w1.w = cvt_pk_bf16(v[14][j], v[15][j]);
                            *(u32x4*)(dp + (size_t)j * D * 2) = w0; *(u32x4*)(dp + (size_t)j * D * 2 + 16) = w1;
                        }
                    }
                }
            }
            }
        }
    } }
    SEAM(0);

    if (IN(1)) {
        const int lane = lane_id_(), tid = wave * 64 + lane; (void)tid; (void)lane;
_Pragma("unroll")
    for (int rep_ = 0; rep_ < NREP(1); ++rep_) { if (rep_) xcd_barrier(bar, wave);
        if (bx == G - 1) {
            for (int i = tid; i < 2048; i += 512) {
                float sn_, cs_; sincosf((float)(i >> 5) * __expf(-9.210340371976184f * (float)(i & 31) * (1.f / 32.f)), &sn_, &cs_);
                ROPE[i] = cs_; ROPE[2048 + i] = sn_;
            }
        }
        for (int row = bx * 8 + wave; row < NROW; row += G * 8) {
            const float* src = row < NLAT ? x + (size_t)row * D : ctx + (size_t)(row - NLAT) * D;
            const float* md = MOD + (size_t)(row < NLAT ? (row >> 11) : 4) * 12288;
            f32x4 v[8]; float ss = 0.f;
#pragma unroll
            for (int i = 0; i < 8; ++i) { v[i] = *(const f32x4*)(src + lane * 4 + 256 * i); ss += v[i][0] * v[i][0] + v[i][1] * v[i][1] + v[i][2] * v[i][2] + v[i][3] * v[i][3]; }
            ss = wave_sum(ss);
            const float rstd = rsqrtf(ss * (1.f / D) + EPS);
#pragma unroll
            for (int i = 0; i < 8; ++i) {
                const int c = lane * 4 + 256 * i;
                const f32x4 gg = *(const f32x4*)(g_norm1 + c), sh = *(const f32x4*)(md + c), sc = *(const f32x4*)(md + 2048 + c);
                const f32x4 y = v[i] * rstd * gg; const f32x4 uu = y * (sc + 1.f) + sh;
                u32x2 o; o.x = cvt_pk_bf16(uu[0], uu[1]); o.y = cvt_pk_bf16(uu[2], uu[3]);
                *(u32x2*)(U + (size_t)row * D + c) = o;
                *(unsigned*)(U8 + (size_t)row * D + c) = pk4_fp8(uu[0], uu[1], uu[2], uu[3]);
            }
        }
    } }
    SEAM(1);

    if (IN(2)) {
        const int lane = lane_id_(), tid = wave * 64 + lane; (void)tid; (void)lane;
_Pragma("unroll")
    for (int rep_ = 0; rep_ < NREP(2); ++rep_) { if (rep_) xcd_barrier(bar, wave);
        {
            SchedInprojA S{G, bx};
            g8::OpsPlain O{U, WTIN, D};
            EpiInprojT<false> E{PM, QR, KR, VV, MG, OG8, GATES, BINP, 1.f, g_q, g_k, ROPE, lds};
            g8::gemm_phase<EpiInprojT<false>, SchedInprojA, g8::OpsPlain>(lds, D * 2, S, O, E, wave);
        }
        {
            SchedInprojB S{G, (G == 256) ? ((bx + 256 - 56) & 255) : bx};
            OpsPlain8 O{U8, WTIN8, 8};
            EpiInprojT<true> E{PM, QR, KR, VV, MG, OG8, GATES, BINP, WINV, g_q, g_k, ROPE, lds};
            g8::gemm_phase<EpiInprojT<true>, SchedInprojB, OpsPlain8, true>(lds, D, S, O, E, wave);
        }
    } }
    SEAM(2);


    using ml::T_GU; using ml::T_CONV;
    if (IN(4)) {
        const int lane = lane_id_(), tid = wave * 64 + lane; (void)tid; (void)lane;
        const bool att_first = (vcu & 1) != 0;
#define ATT_BLOCK() do { _Pragma("unroll 1") for (int rep_ = 0; rep_ < NREP(12); ++rep_) { \
            for (int L = vcu; L < 512; L += G) { \
                const int pair = L >> 5, r = L & 31, b = pair >> 2, kvh = pair & 3, hq = kvh * 4 + (r >> 3), qb = r & 7; \
                const size_t qoff = ((size_t)(b * TSEQ + qb * 256)) * 2048 + hq * 128; \
                const size_t koff = ((size_t)b * KVLEN) * 512 + kvh * 128; \
                att::attn_dense_body(QR + qoff, KR + koff, VV + koff, AO8 + qoff, KVLEN, (char*)lds_raw, lds, wave); \
            } } } while (0)
        if (att_first) { ATT_BLOCK(); __syncthreads(); }
#pragma unroll 1
        for (int rep_ = 0; rep_ < NREP(4); ++rep_) {
            ml::Conv cvs{w_gu, w_dn, WTGU, WTDN, bx * 8 + wave, G * 8};
            for (int un = vcu; un < 256; un += G) {
                const int bh = un >> 4, dir = (un >> 3) & 1, vs = un & 7;
                ml::mlstm_unit(lds, PM, GATES, dir ? HB : HF, bh >> 2, bh & 3, dir, vs, cvs, wave);
            }
            {
                f32x4 cv[16];
#pragma unroll 1
                while (cvs.t < ml::T_CONV) { CV_ISSUE(); CV_FINISH(); }
            }
        }
        __syncthreads();
        if (!att_first) { ATT_BLOCK(); }
#undef ATT_BLOCK
    }
    SEAM(4);

    if (IN(5)) {
        const int lane = lane_id_(), tid = wave * 64 + lane; (void)tid; (void)lane;
_Pragma("unroll")
    for (int rep_ = 0; rep_ < NREP(5); ++rep_) { if (rep_) xcd_barrier(bar, wave);
        for (int it = bx * 8 + wave; it < NLAT * 4; it += G * 8) {
            const int tok = it >> 2, hh = it & 3;
            const size_t off = (size_t)tok * 2048 + hh * 512 + lane * 8;
            const u32x4 a = *(const u32x4*)(HF + off), bq = *(const u32x4*)(HB + off);
            float hs[8];
            hs[0] = bf_lo(a.x) + bf_lo(bq.x); hs[1] = bf_hi(a.x) + bf_hi(bq.x); hs[2] = bf_lo(a.y) + bf_lo(bq.y); hs[3] = bf_hi(a.y) + bf_hi(bq.y);
            hs[4] = bf_lo(a.z) + bf_lo(bq.z); hs[5] = bf_hi(a.z) + bf_hi(bq.z); hs[6] = bf_lo(a.w) + bf_lo(bq.w); hs[7] = bf_hi(a.w) + bf_hi(bq.w);
            float ss = 0.f;
#pragma unroll
            for (int j = 0; j < 8; ++j) ss += hs[j] * hs[j];
            ss = wave_sum(ss);
            const float rstd = rsqrtf(ss * (1.f / 512.f) + EPS);
            const u32x2 ov = *(const u32x2*)(OG8 + (size_t)tok * 2048 + hh * 512 + lane * 8);
            const f32x4 g0 = *(const f32x4*)(g_mh + hh * 512 + lane * 8), g1 = *(const f32x4*)(g_mh + hh * 512 + lane * 8 + 4);
            float op[8] = {(float)(ov.x & 0xffu), (float)((ov.x >> 8) & 0xffu), (float)((ov.x >> 16) & 0xffu), (float)(ov.x >> 24), (float)(ov.y & 0xffu), (float)((ov.y >> 8) & 0xffu), (float)((ov.y >> 16) & 0xffu), (float)(ov.y >> 24)};
            float r[8];
#pragma unroll
            for (int j = 0; j < 8; ++j) r[j] = hs[j] * (rstd * (1.f / 255.f)) * (j < 4 ? g0[j] : g1[j - 4]) * op[j];
            u32x2 o; o.x = pk4_fp8(r[0], r[1], r[2], r[3]); o.y = pk4_fp8(r[4], r[5], r[6], r[7]);
            *(u32x2*)(MX8 + off) = o;
        }
    } }
    SEAM(5);

    if (IN(6)) {
        const int lane = lane_id_(), tid = wave * 64 + lane; (void)tid; (void)lane;
_Pragma("unroll")
    for (int rep_ = 0; rep_ < NREP(6); ++rep_) { if (rep_) xcd_barrier(bar, wave);
        SchedDual S{G, bx};
        OpsDual O{MX8, AO8, W8BRM, W8BRA};
        EpiMerge E{MG, MRG8};
        g8::gemm_phase<EpiMerge, SchedDual, OpsDual, true>(lds, D, S, O, E, wave);
    } }
    SEAM(6);

    if (IN(7)) {
        const int lane = lane_id_(), tid = wave * 64 + lane; (void)tid; (void)lane;
_Pragma("unroll")
    for (int rep_ = 0; rep_ < NREP(7); ++rep_) { if (rep_) xcd_barrier(bar, wave);
        SchedSquare S{G, bx, 32, 8};
        OpsPlain8 O{MRG8, W8OUT, 0};
        EpiOut E{x, MOD, HX1, 1.f / (WSCALE * MRG_SCALE)};
        g8::gemm_phase<EpiOut, SchedSquare, OpsPlain8, true>(lds, D, S, O, E, wave);
    } }
    SEAM(7);

    if (IN(8)) {
        const int lane = lane_id_(), tid = wave * 64 + lane; (void)tid; (void)lane;
        LAS float* ut = (LAS float*)lds;
        LAS float* part = (LAS float*)(lds + 65536);
        LAS float* lg = (LAS float*)(lds + 65536 + 16384);
        LAS int* asg_tok = (LAS int*)(lds + 65536 + 16384 + 1024);
        LAS int* asg_e = asg_tok + 256; LAS float* asg_w = (LAS float*)(asg_e + 256);
        LAS int* hist = asg_e + 512; LAS int* hbase = hist + 32;
        int nit = 0;
#define P8_FLUSH() do {     \
            const int nas = nit * 32; \
            if (tid < 32) hist[tid] = 0; \
            __syncthreads(); \
            int my_e = 0, my_rank = 0; \
            if (tid < nas) { my_e = asg_e[tid]; my_rank = atomicAdd((int*)&hist[my_e], 1); } \
            __syncthreads(); \
            if (tid < 32) { const int c_ = hist[tid]; hbase[tid] = c_ ? (int)atomicAdd(&ECNT[tid], (unsigned)c_) : 0; } \
            __syncthreads(); \
            if (tid < nas) { \
                const int pos_ = hbase[my_e] + my_rank, tok_ = asg_tok[tid]; \
                LIST[my_e * NLAT + pos_] = tok_; \
                TOPE[tok_ * 4 + (tid & 3)] = my_e; TOPP[tok_ * 4 + (tid & 3)] = pos_; TOPW[tok_ * 4 + (tid & 3)] = asg_w[tid]; \
            } \
            __syncthreads(); nit = 0; } while (0)
        const int e = lane & 31, jh = lane >> 5, jb = wave * 256 + jh * 128;
        float wv[128];
        {
            const float* wrp = w_router + (size_t)jb * 32 + e;
#pragma unroll
            for (int q = 0; q < 128; ++q) wv[q] = wrp[q * 32];
        }
        u32x4 hv[4];
#define P8_LOADV(T0) do { const bf16_t* src_ = HX1 + (size_t)((T0) + wave) * D; _Pragma("unroll") for (int i = 0; i < 4; ++i) hv[i] = *(const u32x4*)(src_ + lane * 8 + 512 * i); } while (0)
        LAS float* gsv = (LAS float*)(lds + 96 * 1024); LAS float* shv = (LAS float*)(lds + 104 * 1024);
        const int nblk = NLAT / 8, per_ = (nblk + G - 1) / G, blk0 = bx * per_, blk1 = (blk0 + per_ < nblk) ? blk0 + per_ : nblk;
        int cur_b = -1;
        if (blk0 < blk1) P8_LOADV(blk0 * 8);
        for (int blk = blk0; blk < blk1; ++blk) {
            const int t0 = blk * 8;
            if ((t0 >> 11) != cur_b) {
                cur_b = t0 >> 11;
                const float* md = MOD + (size_t)cur_b * 12288; const int c = tid * 4;
                const f32x4 gg = *(const f32x4*)(g_norm2 + c), sh = *(const f32x4*)(md + 6144 + c), sc = *(const f32x4*)(md + 8192 + c);
                *(LAS f32x4*)(gsv + c) = gg * (sc + 1.f); *(LAS f32x4*)(shv + c) = sh;
                __syncthreads();
            }
            {
                const int tok = t0 + wave;
                f32x4 v[8]; float ss = 0.f;
#pragma unroll
                for (int i = 0; i < 4; ++i) {
                    v[2 * i] = (f32x4){bf_lo(hv[i].x), bf_hi(hv[i].x), bf_lo(hv[i].y), bf_hi(hv[i].y)}; v[2 * i + 1] = (f32x4){bf_lo(hv[i].z), bf_hi(hv[i].z), bf_lo(hv[i].w), bf_hi(hv[i].w)};
                }
#pragma unroll
                for (int i = 0; i < 8; ++i) ss += v[i][0] * v[i][0] + v[i][1] * v[i][1] + v[i][2] * v[i][2] + v[i][3] * v[i][3];
                ss = wave_sum(ss);
                const float rstd = rsqrtf(ss * (1.f / D) + EPS);
#pragma unroll
                for (int i = 0; i < 4; ++i) {
                    const int c = lane * 8 + 512 * i;
                    const f32x4 u0 = v[2 * i] * rstd * *(const LAS f32x4*)(gsv + c) + *(const LAS f32x4*)(shv + c);
                    const f32x4 u1 = v[2 * i + 1] * rstd * *(const LAS f32x4*)(gsv + c + 4) + *(const LAS f32x4*)(shv + c + 4);
                    *(LAS f32x4*)(ut + wave * 2048 + c) = u0; *(LAS f32x4*)(ut + wave * 2048 + c + 4) = u1;
                    u32x2 w8; w8.x = pk4_fp8(u0[0], u0[1], u0[2], u0[3]); w8.y = pk4_fp8(u1[0], u1[1], u1[2], u1[3]);
                    *(u32x2*)(U2 + (size_t)tok * D + c) = w8;
                }
            }
            if (blk + 1 < blk1) P8_LOADV(t0 + 8);
            __syncthreads();
            {
                float a[8] = {0.f, 0.f, 0.f, 0.f, 0.f, 0.f, 0.f, 0.f};
#pragma unroll
                for (int th = 0; th < 8; th += 4) {
                    f32x4 ua[4], ub[4];
#pragma unroll
                    for (int tk = 0; tk < 4; ++tk) ua[tk] = *(const LAS f32x4*)(ut + (th + tk) * 2048 + jb);
#pragma unroll
                    for (int jj = 0; jj < 128; jj += 8) {
#pragma unroll
                        for (int tk = 0; tk < 4; ++tk) ub[tk] = *(const LAS f32x4*)(ut + (th + tk) * 2048 + jb + jj + 4);
#pragma unroll
                        for (int tk = 0; tk < 4; ++tk) a[th + tk] += ua[tk][0] * wv[jj] + ua[tk][1] * wv[jj + 1] + ua[tk][2] * wv[jj + 2] + ua[tk][3] * wv[jj + 3];
                        if (jj + 8 < 128) {
#pragma unroll
                            for (int tk = 0; tk < 4; ++tk) ua[tk] = *(const LAS f32x4*)(ut + (th + tk) * 2048 + jb + jj + 8);
                        }
#pragma unroll
                        for (int tk = 0; tk < 4; ++tk) a[th + tk] += ub[tk][0] * wv[jj + 4] + ub[tk][1] * wv[jj + 5] + ub[tk][2] * wv[jj + 6] + ub[tk][3] * wv[jj + 7];
                    }
                }
#pragma unroll
                for (int tk = 0; tk < 8; ++tk) part[((wave * 2 + jh) * 8 + tk) * 32 + e] = a[tk];
            }
            __syncthreads();
            {
                const int tok = t0 + wave;
                float v = -INFINITY;
                if (lane < 32) { float s = b_router[lane];
#pragma unroll
                    for (int p = 0; p < 16; ++p) s += part[(p * 8 + wave) * 32 + lane];
                    v = s; }
                float tl[4]; int te[4];
#pragma unroll
                for (int k = 0; k < 4; ++k) {
                    const float mx = wave_max(v);
                    const unsigned long long bm = __ballot(v == mx);
                    const int e = __ffsll((long long)bm) - 1;
                    tl[k] = mx; te[k] = e;
                    if (lane == e) v = -INFINITY;
                }
                const float e1 = __expf(tl[1] - tl[0]), e2 = __expf(tl[2] - tl[0]), e3 = __expf(tl[3] - tl[0]);
                const float inv = 1.f / (1.f + e1 + e2 + e3);
                if (lane < 4) {
                    const int e = lane == 0 ? te[0] : (lane == 1 ? te[1] : (lane == 2 ? te[2] : te[3]));
                    const float wgt = (lane == 0 ? 1.f : (lane == 1 ? e1 : (lane == 2 ? e2 : e3))) * inv;
                    const int slot = (nit * 8 + wave) * 4 + lane;
                    asg_tok[slot] = tok; asg_e[slot] = e; asg_w[slot] = wgt;
                }
            }
            ++nit;
            __syncthreads();
            if (nit == 8) P8_FLUSH();
        }
        if (nit > 0) P8_FLUSH();
#undef P8_FLUSH
#undef P8_LOADV
    }
    SEAM(8);

    volatile LAS int* mstart = (volatile LAS int*)(MISC + 16);
    volatile LAS int* ecnt_l = (volatile LAS int*)(MISC + 52);
    volatile LAS int* texp_l = (volatile LAS int*)(MISC + 88);
    if (IN(9) || IN(10) || IN(11)) {
        const int lane = lane_id_();
        if (wave == 0) {
            const int c = lane < 32 ? (int)__hip_atomic_load(&ECNT[lane & 31], __ATOMIC_RELAXED, __HIP_MEMORY_SCOPE_AGENT) : 0;
            int n = (c + 255) >> 8;
#pragma unroll
            for (int o = 1; o < 64; o <<= 1) { const int t = __shfl_up(n, o, 64); if (lane >= o) n += t; }
            if (lane < 32) { mstart[lane + 1] = n; ecnt_l[lane] = c; }
            if (lane == 0) mstart[0] = 0;
        }
        volatile LAS int* tbw = (volatile LAS int*)(lds + XS_OFF);
        if (wave == 0) {
            const int c = lane < 32 ? ecnt_l[lane & 31] : 0;
            const int F = c >> 8, R = ((c + 255) >> 8) - F;
            int nf = F, nr = R;
#pragma unroll
            for (int o = 1; o < 64; o <<= 1) { const int t = __shfl_up(nf, o, 64), t2 = __shfl_up(nr, o, 64); if (lane >= o) { nf += t; nr += t2; } }
            if (lane < 32) { tbw[lane + 1] = nf; if (R) tbw[40 + nr - 1] = lane; }
            if (lane == 0) tbw[0] = 0;
            if (lane == 31) tbw[80] = nr;
        }
        __syncthreads();
        {
            const int tid2 = wave * 64 + lane;
            if (tid2 < 32) { const int a = mstart[tid2], b = mstart[tid2 + 1]; for (int t = a; t < b; ++t) texp_l[t] = tid2; }
            if (tid2 >= 64 && tid2 < 96) { const int e2 = tid2 - 64, a = tbw[e2], b = tbw[e2 + 1]; for (int t = a; t < b; ++t) tbw[96 + t] = e2; }
        }
        __syncthreads();
    }
    if (IN(9)) {
        const int lane = lane_id_(), tid = wave * 64 + lane; (void)tid; (void)lane;
_Pragma("unroll")
    for (int rep_ = 0; rep_ < NREP(9); ++rep_) { if (rep_) xcd_barrier(bar, wave);
        SchedMoe S{G, vcu, 16, mstart, ecnt_l, (const volatile LAS int*)(lds + XS_OFF)};
        OpsMoe1 O{U2, WTGU, LIST, ecnt_l};
        EpiMoe1 E{HID, b_gu};
        g8::gemm_phase<EpiMoe1, SchedMoe, OpsMoe1, true>(lds, D, S, O, E, wave);
    } }
    SEAM(9);
    if (IN(10)) {
        const int lane = lane_id_(), tid = wave * 64 + lane; (void)tid; (void)lane;
_Pragma("unroll")
    for (int rep_ = 0; rep_ < NREP(10); ++rep_) { if (rep_) xcd_barrier(bar, wave);
        SchedMoe S{G, vcu, 8, mstart, ecnt_l, (const volatile LAS int*)(lds + XS_OFF)};
        OpsMoe2 O{HID, WTDN};
        EpiMoe2 E{Y, b_dn};
        g8::gemm_phase<EpiMoe2, SchedMoe, OpsMoe2, true>(lds, D, S, O, E, wave);
    } }
    SEAM(10);

    if (IN(11)) {
        const int lane = lane_id_(), tid = wave * 64 + lane; (void)tid; (void)lane;
        for (int tok = bx * 8 + wave; tok < NLAT; tok += G * 8) {
            const float* md = MOD + (size_t)(tok >> 11) * 12288 + 10240;
            size_t ro[4]; float wk[4];
#pragma unroll
            for (int k = 0; k < 4; ++k) { const int e = TOPE[tok * 4 + k]; ro[k] = ((size_t)mstart[e] * 256 + TOPP[tok * 4 + k]) * 2048; wk[k] = TOPW[tok * 4 + k]; }
#pragma unroll
            for (int i = 0; i < 4; ++i) {
                const int c = lane * 8 + 512 * i;
                float s[8] = {0.f, 0.f, 0.f, 0.f, 0.f, 0.f, 0.f, 0.f};
#pragma unroll
                for (int k = 0; k < 4; ++k) {
                    const u32x4 yv = *(const u32x4*)(Y + ro[k] + c);
                    s[0] += wk[k] * bf_lo(yv.x); s[1] += wk[k] * bf_hi(yv.x); s[2] += wk[k] * bf_lo(yv.y); s[3] += wk[k] * bf_hi(yv.y);
                    s[4] += wk[k] * bf_lo(yv.z); s[5] += wk[k] * bf_hi(yv.z); s[6] += wk[k] * bf_lo(yv.w); s[7] += wk[k] * bf_hi(yv.w);
                }
                float* op = out + (size_t)tok * D + c;
                const u32x4 hq = *(const u32x4*)(HX1 + (size_t)tok * D + c);
                const f32x4 h0 = (f32x4){bf_lo(hq.x), bf_hi(hq.x), bf_lo(hq.y), bf_hi(hq.y)}, h1 = (f32x4){bf_lo(hq.z), bf_hi(hq.z), bf_lo(hq.w), bf_hi(hq.w)};
                const f32x4 g0 = *(const f32x4*)(md + c), g1 = *(const f32x4*)(md + c + 4);
                f32x4 r0, r1;
#pragma unroll
                for (int j = 0; j < 4; ++j) { r0[j] = h0[j] + g0[j] * s[j]; r1[j] = h1[j] + g1[j] * s[4 + j]; }
                *(f32x4*)op = r0; *(f32x4*)(op + 4) = r1;
            }
        }
    }
#undef IN
#undef SEAM
}

#ifndef MK_SPLIT
#define MK_SPLIT 0
#endif
constexpr int NPHASE = 12;
extern "C" void kernel_launch(void* const* d_in, const int* in_sizes, int n_in, void* d_out, int out_size, void* d_ws, size_t ws_size, hipStream_t stream) {
    static int grid = 0;
    if (grid == 0) {
        if (n_in != 22 || out_size != NLAT * D || ws_size < WS_END) { fprintf(stderr, "kernel_launch: unexpected shapes (n_in %d out %d ws %zu need %zu)\n", n_in, out_size, ws_size, (size_t)WS_END); grid = -1; return; }
        int dev = 0, cus = 0, per_cu = 0;
        if (hipGetDevice(&dev) != hipSuccess || hipDeviceGetAttribute(&cus, hipDeviceAttributeMultiprocessorCount, dev) != hipSuccess) { grid = -1; return; }
        if (hipFuncSetAttribute((const void*)fwd, hipFuncAttributeMaxDynamicSharedMemorySize, LDS_TOTAL) != hipSuccess) { fprintf(stderr, "kernel_launch: hipFuncSetAttribute failed\n"); grid = -1; return; }
        if (hipOccupancyMaxActiveBlocksPerMultiprocessor(&per_cu, (const void*)fwd, NTHREADS, LDS_TOTAL) != hipSuccess || per_cu < 1) fprintf(stderr, "kernel_launch: occupancy query says %d\n", per_cu);
        (void)hipGetLastError();
        grid = cus;
    }
    if (grid < 0) return;
    if (hipMemsetAsync((char*)d_ws + WS_CTL, 0, CTL_BYTES, stream) != hipSuccess) return;
    Args a{};
    for (int i = 0; i < 22; ++i) a.in[i] = (const float*)d_in[i];
    a.out = (float*)d_out; a.ws = (unsigned char*)d_ws;
#if MK_SPLIT
    for (int p = 0; p < NPHASE; ++p) { a.ph_lo = p; a.ph_hi = p + 1; hipLaunchKernelGGL(fwd, dim3(grid), dim3(NTHREADS), LDS_TOTAL, stream, a); }
#else
    a.ph_lo = 0; a.ph_hi = NPHASE;
    hipLaunchKernelGGL(fwd, dim3(grid), dim3(NTHREADS), LDS_TOTAL, stream, a);
#endif
}
```

```cpp
#include <hip/hip_runtime.h>
#include <stdint.h>
#include <stdio.h>

#define LAS __attribute__((address_space(3)))
typedef unsigned short bf16_t;
typedef short bf16x8 __attribute__((ext_vector_type(8)));
typedef short s16x4 __attribute__((ext_vector_type(4)));
typedef float f32x4 __attribute__((ext_vector_type(4)));
typedef float f32x16 __attribute__((ext_vector_type(16)));
typedef unsigned u32x4 __attribute__((ext_vector_type(4)));
typedef unsigned u32x2 __attribute__((ext_vector_type(2)));

constexpr int D = 2048, NB = 4, TSEQ = 2048, NCTXB = 256;
constexpr int NLAT = NB * TSEQ;
constexpr int NCTX = NB * NCTXB;
constexpr int NROW = NLAT + NCTX;
constexpr int F_IN = 13328, NP = 13568;
constexpr int NE = 32;
constexpr int KVLEN = TSEQ + NCTXB;
constexpr int NTHREADS = 512;
#ifndef REP_MASK
#define REP_MASK 0
#endif
constexpr float EPS = 1e-6f;

constexpr size_t al256(size_t x) { return (x + 255) & ~(size_t)255; }
constexpr size_t WS_CTL   = 0;
constexpr size_t CTL_BYTES = 65536;
constexpr size_t WS_MOD   = WS_CTL + CTL_BYTES;
constexpr size_t WS_BINP  = al256(WS_MOD + 5 * 12288 * 4);
constexpr size_t WS_WTIN  = al256(WS_BINP + NP * 4);
constexpr size_t WS_WTBRM = al256(WS_WTIN + (size_t)NP * D * 2);
constexpr size_t WS_WTBRA = WS_WTBRM + (size_t)D * D * 2;
constexpr size_t WS_WTOUT = WS_WTBRA + (size_t)D * D * 2;
constexpr size_t WS_WTGU  = WS_WTOUT + (size_t)D * D * 2;
constexpr size_t WS_WTDN  = WS_WTGU + (size_t)NE * 4096 * D;
constexpr size_t WS_U     = WS_WTDN + (size_t)NE * D * D;
constexpr size_t WS_PM    = WS_U + (size_t)NROW * D * 2;
constexpr size_t WS_GATES = WS_PM + (size_t)NROW * 6144 * 2;
constexpr size_t WS_AQ    = al256(WS_GATES + (size_t)NROW * 16 * 4);
constexpr size_t WS_AK    = WS_AQ + (size_t)NLAT * D * 2;
constexpr size_t WS_VV    = WS_AK + (size_t)NROW * 512 * 2;
constexpr size_t WS_KR    = WS_VV + (size_t)NROW * 512 * 2;
constexpr size_t WS_QR    = WS_KR + (size_t)NROW * 512 * 2;
constexpr size_t WS_MG    = WS_QR + (size_t)NLAT * D * 2;
constexpr size_t WS_AO    = WS_MG + (size_t)NLAT * 4096 * 2;
constexpr size_t WS_HF    = WS_AO + (size_t)NLAT * D * 2;
constexpr size_t WS_HB    = WS_HF + (size_t)NLAT * D * 2;
constexpr size_t WS_MX    = WS_HB + (size_t)NLAT * D * 2;
constexpr size_t WS_MRG   = WS_MX + (size_t)NLAT * D * 2;
constexpr size_t WS_U2    = WS_MRG + (size_t)NLAT * D * 2;
constexpr size_t WS_TOPE  = WS_U2 + (size_t)NLAT * D;
constexpr size_t WS_TOPP  = WS_TOPE + (size_t)NLAT * 4 * 4;
constexpr size_t WS_TOPW  = WS_TOPP + (size_t)NLAT * 4 * 4;
constexpr size_t WS_LIST  = WS_TOPW + (size_t)NLAT * 4 * 4;
constexpr int    MAXROWS  = 40960;
constexpr size_t WS_HID   = WS_LIST + (size_t)NE * NLAT * 4;
constexpr size_t WS_Y     = WS_HID + (size_t)MAXROWS * D;
constexpr size_t WS_WTIN8 = WS_Y + (size_t)MAXROWS * D * 2;
constexpr size_t WS_U8    = WS_WTIN8 + (size_t)11264 * D;
constexpr size_t WS_W8BRM = WS_U8 + (size_t)NROW * D;
constexpr size_t WS_W8BRA = WS_W8BRM + (size_t)D * D;
constexpr size_t WS_W8OUT = WS_W8BRA + (size_t)D * D;
constexpr size_t WS_MX8   = WS_W8OUT + (size_t)D * D;
constexpr size_t WS_AO8   = WS_MX8 + (size_t)NLAT * D;
constexpr size_t WS_MRG8  = WS_AO8 + (size_t)NLAT * D;
constexpr size_t WS_ROPE  = WS_MRG8 + (size_t)NLAT * D;
constexpr size_t WS_HX1   = WS_ROPE + 4096 * 4;
constexpr size_t WS_END   = WS_HX1 + (size_t)NLAT * D * 2;

constexpr int CW_BAR = 0;
constexpr int CW_CNT = 4096;

constexpr int LDS_TOTAL = 144 * 1024;
constexpr int XS_OFF    = 136 * 1024;
constexpr int MISC_OFF  = 135 * 1024;

__device__ __forceinline__ unsigned cvt_pk_bf16(float lo, float hi) { unsigned r; asm volatile("v_cvt_pk_bf16_f32 %0, %1, %2" : "=v"(r) : "v"(lo), "v"(hi)); return r; }
__device__ __forceinline__ float bf_lo(unsigned w) { return __uint_as_float(w << 16); }
__device__ __forceinline__ float bf_hi(unsigned w) { return __uint_as_float(w & 0xffff0000u); }
__device__ __forceinline__ float bf_s(unsigned short h) { return __uint_as_float(((unsigned)h) << 16); }
__device__ __forceinline__ float wave_sum(float v) {
    v += __int_as_float(__builtin_amdgcn_update_dpp(0, __float_as_int(v), 0xB1, 0xf, 0xf, false));
    v += __int_as_float(__builtin_amdgcn_update_dpp(0, __float_as_int(v), 0x4E, 0xf, 0xf, false));
    v += __int_as_float(__builtin_amdgcn_update_dpp(0, __float_as_int(v), 0x141, 0xf, 0xf, false));
    v += __int_as_float(__builtin_amdgcn_update_dpp(0, __float_as_int(v), 0x140, 0xf, 0xf, false));
    v += __int_as_float(__builtin_amdgcn_update_dpp(0, __float_as_int(v), 0x142, 0xa, 0xf, false));
    v += __int_as_float(__builtin_amdgcn_update_dpp(0, __float_as_int(v), 0x143, 0xc, 0xf, false));
    return __int_as_float(__builtin_amdgcn_readlane(__float_as_int(v), 63));
}
__device__ __forceinline__ float wave_max(float v) {
    v = fmaxf(v, __int_as_float(__builtin_amdgcn_update_dpp(__float_as_int(v), __float_as_int(v), 0xB1, 0xf, 0xf, false)));
    v = fmaxf(v, __int_as_float(__builtin_amdgcn_update_dpp(__float_as_int(v), __float_as_int(v), 0x4E, 0xf, 0xf, false)));
    v = fmaxf(v, __int_as_float(__builtin_amdgcn_update_dpp(__float_as_int(v), __float_as_int(v), 0x141, 0xf, 0xf, false)));
    v = fmaxf(v, __int_as_float(__builtin_amdgcn_update_dpp(__float_as_int(v), __float_as_int(v), 0x140, 0xf, 0xf, false)));
    v = fmaxf(v, __int_as_float(__builtin_amdgcn_update_dpp(__float_as_int(v), __float_as_int(v), 0x142, 0xa, 0xf, false)));
    v = fmaxf(v, __int_as_float(__builtin_amdgcn_update_dpp(__float_as_int(v), __float_as_int(v), 0x143, 0xc, 0xf, false)));
    return __int_as_float(__builtin_amdgcn_readlane(__float_as_int(v), 63));
}
__device__ __forceinline__ int lane_id_() { int l; asm volatile("v_mbcnt_lo_u32_b32 %0, -1, 0\n\tv_mbcnt_hi_u32_b32 %0, -1, %0" : "=v"(l)); return l; }
__device__ __forceinline__ float wave_scan_add(float v) {
    v += __int_as_float(__builtin_amdgcn_update_dpp(0, __float_as_int(v), 0x111, 0xf, 0xf, false));
    v += __int_as_float(__builtin_amdgcn_update_dpp(0, __float_as_int(v), 0x112, 0xf, 0xf, false));
    v += __int_as_float(__builtin_amdgcn_update_dpp(0, __float_as_int(v), 0x114, 0xf, 0xf, false));
    v += __int_as_float(__builtin_amdgcn_update_dpp(0, __float_as_int(v), 0x118, 0xf, 0xf, false));
    v += __int_as_float(__builtin_amdgcn_update_dpp(0, __float_as_int(v), 0x142, 0xa, 0xf, false));
    v += __int_as_float(__builtin_amdgcn_update_dpp(0, __float_as_int(v), 0x143, 0xc, 0xf, false));
    return v;
}
__device__ __forceinline__ float wave_scan_max(float v) {
    const int NI = (int)0xff800000u;
    v = fmaxf(v, __int_as_float(__builtin_amdgcn_update_dpp(NI, __float_as_int(v), 0x111, 0xf, 0xf, false)));
    v = fmaxf(v, __int_as_float(__builtin_amdgcn_update_dpp(NI, __float_as_int(v), 0x112, 0xf, 0xf, false)));
    v = fmaxf(v, __int_as_float(__builtin_amdgcn_update_dpp(NI, __float_as_int(v), 0x114, 0xf, 0xf, false)));
    v = fmaxf(v, __int_as_float(__builtin_amdgcn_update_dpp(NI, __float_as_int(v), 0x118, 0xf, 0xf, false)));
    v = fmaxf(v, __int_as_float(__builtin_amdgcn_update_dpp(NI, __float_as_int(v), 0x142, 0xa, 0xf, false)));
    v = fmaxf(v, __int_as_float(__builtin_amdgcn_update_dpp(NI, __float_as_int(v), 0x143, 0xc, 0xf, false)));
    return v;
}
__device__ __forceinline__ float sum8_dpp(float v) {
    v += __int_as_float(__builtin_amdgcn_update_dpp(0, __float_as_int(v), 0xB1, 0xf, 0xf, false));
    v += __int_as_float(__builtin_amdgcn_update_dpp(0, __float_as_int(v), 0x4E, 0xf, 0xf, false));
    v += __int_as_float(__builtin_amdgcn_update_dpp(0, __float_as_int(v), 0x141, 0xf, 0xf, false));
    return v;
}
__device__ __forceinline__ float sigmoidf_(float x) { return __builtin_amdgcn_rcpf(1.f + __expf(-x)); }

__device__ __forceinline__ unsigned pk4_fp8(float a, float b, float c, float d) {
    int w = 0;
    w = __builtin_amdgcn_cvt_pk_fp8_f32(a, b, w, false);
    w = __builtin_amdgcn_cvt_pk_fp8_f32(c, d, w, true);
    return (unsigned)w;
}
constexpr float WSCALE = 32.f, WINV = 1.f / 32.f;

#define XB_TMO      128
#define XB_XCNT(j)  (256  + 64 * (j))
#define XB_XSUB(j)  (1280 + 64 * (j))
#define XB_XGEN(j)  (2304 + 64 * (j))
#define XB_TOP      3328
#define XB_TOPGEN   3392
#define XCD_BAR_WORDS 3456
#define XB_SPIN_CAP (1u << 22)

__device__ __forceinline__ unsigned xb_ld(unsigned* p)              { return __hip_atomic_load(p, __ATOMIC_RELAXED, __HIP_MEMORY_SCOPE_AGENT); }
__device__ __forceinline__ unsigned xb_add(unsigned* p, unsigned v) { return __hip_atomic_fetch_add(p, v, __ATOMIC_RELAXED, __HIP_MEMORY_SCOPE_AGENT); }
__device__ __forceinline__ unsigned xb_xcc_id() { return (unsigned)__builtin_amdgcn_s_getreg((3 << 11) | 20) & 0xFu; }
#define XB_SPIN(cond, bar) do { unsigned _sp = 0; while (cond) { __builtin_amdgcn_s_sleep(1); \
    if ((++_sp & 255u) == 0u) { if (xb_ld(&(bar)[XB_TMO])) break; if (_sp > XB_SPIN_CAP) { atomicAdd(&(bar)[XB_TMO], 1u); break; } } } } while (0)

struct XcdBarrier { unsigned* bar; unsigned x; volatile LAS unsigned* st; };

__device__ __forceinline__ XcdBarrier xcd_barrier_post(unsigned* bar, volatile LAS unsigned* st, bool leader) {
    XcdBarrier b; b.bar = bar; b.x = xb_xcc_id(); b.st = st;
    if (leader) (void)xb_add(&bar[XB_XCNT(b.x)], 1u);
    return b;
}
__device__ __forceinline__ void xcd_barrier_complete(unsigned* bar, unsigned x, unsigned& nloc, unsigned& nx) {
    const unsigned G = gridDim.x * gridDim.y * gridDim.z;
    unsigned sum, cnt, mine, sp = 0u;
    for (;;) {
        sum = 0u; cnt = 0u; mine = 0u;
#pragma unroll
        for (unsigned j = 0; j < 16; ++j) { const unsigned c = xb_ld(&bar[XB_XCNT(j)]); sum += c; cnt += (c > 0u) ? 1u : 0u; mine = (j == x) ? c : mine; }
        if (sum == G) break;
        __builtin_amdgcn_s_sleep(1);
        if ((++sp & 255u) == 0u) { if (xb_ld(&bar[XB_TMO])) break; if (sp > XB_SPIN_CAP) { atomicAdd(&bar[XB_TMO], 1u); break; } }
    }
    nloc = mine > 0u ? mine : 1u; nx = cnt > 0u ? cnt : 1u;
}
__device__ __forceinline__ void xcd_barrier(const XcdBarrier& b, int wave_) {
    asm volatile("s_waitcnt vmcnt(0)" ::: "memory");
    __syncthreads();
    if (wave_ == 0 && lane_id_() == 0) {
        unsigned* bar = b.bar;
        __builtin_amdgcn_s_waitcnt(0);
        unsigned nloc = b.st[0], nx = b.st[1];
        if (nloc == 0u) { xcd_barrier_complete(bar, b.x, nloc, nx); b.st[0] = nloc; b.st[1] = nx; }
        const unsigned old = xb_add(&bar[XB_XSUB(b.x)], 1u);
        const unsigned gen = old / nloc;
        if (old + 1u == (gen + 1u) * nloc) {
            __builtin_amdgcn_fence(__ATOMIC_RELEASE, "agent");
            asm volatile("s_waitcnt vmcnt(0)" ::: "memory");
            const unsigned og = xb_add(&bar[XB_TOP], 1u);
            const unsigned tg = og / nx;
            if (og + 1u == (tg + 1u) * nx) xb_add(&bar[XB_TOPGEN], 1u);
            else XB_SPIN(xb_ld(&bar[XB_TOPGEN]) == tg, bar);
            __builtin_amdgcn_fence(__ATOMIC_ACQUIRE, "agent");
            xb_add(&bar[XB_XGEN(b.x)], 1u);
            asm volatile("s_waitcnt vmcnt(0)" ::: "memory");
        } else {
            XB_SPIN(xb_ld(&bar[XB_XGEN(b.x)]) == gen, bar);
            __builtin_amdgcn_fence(__ATOMIC_ACQUIRE, "agent");
            asm volatile("s_waitcnt vmcnt(0)" ::: "memory");
        }
    }
    __syncthreads();
}

struct Args {
    const float* in[22];
    float* out;
    unsigned char* ws;
    int ph_lo, ph_hi;
};

namespace g8 {
constexpr int BM = 256, BK = 64, HALF = 128, HTB = HALF * BK * 2, STAGE_BYTES = 8 * HTB;
__device__ __forceinline__ int lds_byte(int r, int c) { const int st = (r >> 4) * 2 + (c >> 5), rr = r & 15, cc = c & 31, ob = rr * 64 + cc * 2; return st * 1024 + (ob ^ (((ob >> 9) & 1) << 5)); }
__device__ __forceinline__ void stage_rc(int b, int& R, int& C) { const int st = b / 1024, sb = b % 1024, swz = sb ^ (((sb >> 9) & 1) << 5); R = (st >> 1) * 16 + swz / 64; C = (st & 1) * 32 + (swz % 64) / 2; }
__device__ __forceinline__ int perm32(int rho) { const int n = rho >> 4, i = rho & 15; return 8 * (i >> 2) + 4 * n + (i & 3); }

struct Unit { int pm, pn, e, mt, hm, hn; };
typedef f32x4 Acc[2][2][4][2];
typedef int v8i __attribute__((ext_vector_type(8)));
typedef int v4i __attribute__((ext_vector_type(4)));
__device__ __forceinline__ void mfma8(f32x4& acc, v8i a, v8i b, int sc) {
    (void)sc;
    asm volatile("v_mfma_f32_16x16x128_f8f6f4 %0, %1, %2, %0" : "+v"(acc) : "v"(a), "v"(b));
}
__device__ __forceinline__ v8i cat8(bf16x8 lo, bf16x8 hi) { const v4i a = __builtin_bit_cast(v4i, lo), b = __builtin_bit_cast(v4i, hi); return __builtin_shufflevector(a, b, 0, 1, 2, 3, 4, 5, 6, 7); }

template <class Epi, class Sched, class Ops, bool FP8 = false>
__device__ __forceinline__ void gemm_phase(LAS unsigned char* lds, const int RB, const Sched& S, const Ops& G, const Epi& E, const int wave_) {
    const int wid = wave_, lane = lane_id_(), tid = wid * 64 + lane, wr = wid >> 2, wc = wid & 3, fr = lane & 15, fq = lane >> 4;
    const int nt = RB / 128;
    int R0, C0, R1, C1; stage_rc(tid * 16, R0, C0); stage_rc(tid * 16 + 8192, R1, C1);
    unsigned voffB[2];
    { const int Rb0 = Epi::PERM ? ((R0 & ~31) + perm32(R0 & 31)) : R0, Rb1 = Epi::PERM ? ((R1 & ~31) + perm32(R1 & 31)) : R1;
      voffB[0] = (unsigned)(Rb0 * RB + C0 * 2); voffB[1] = (unsigned)(Rb1 * RB + C1 * 2); }
    const size_t kstep = (size_t)128;
    const size_t hstep = (size_t)HALF * RB;
    const unsigned ldsw = (unsigned)wid * 1024u;
    const int aoff = lds_byte(wr * 64 + fr, fq * 8), boff = lds_byte(wc * 32 + fr, fq * 8);
#define G8_SA(b, h) (((b) * 2 + (h)) * HTB)
#define G8_SB(b, h) ((4 + (b) * 2 + (h)) * HTB)
#define G8_STAGE2(bufoff, gbase, v0, v1) do { \
        __builtin_amdgcn_global_load_lds((const unsigned*)((const char*)(gbase) + (v0)), (LAS unsigned*)(lds + (bufoff) + ldsw), 16, 0, 0); \
        __builtin_amdgcn_global_load_lds((const unsigned*)((const char*)(gbase) + (v1)), (LAS unsigned*)(lds + (bufoff) + ldsw + 8192), 16, 0, 0); } while (0)
#define G8_LDA(dst, b, h) do { _Pragma("unroll") for (int m = 0; m < 4; ++m) _Pragma("unroll") for (int k = 0; k < 2; ++k) dst[m][k] = *(const LAS bf16x8*)(lds + G8_SA(b, h) + aoff + m * 2048 + k * 1024); } while (0)
#define G8_LDB(dst, b, h) do { _Pragma("unroll") for (int n = 0; n < 2; ++n) _Pragma("unroll") for (int k = 0; k < 2; ++k) dst[n][k] = *(const LAS bf16x8*)(lds + G8_SB(b, h) + boff + n * 2048 + k * 1024); } while (0)
#define G8_MMA(ai, bj, At, Bt) do { __builtin_amdgcn_s_setprio(1); \
        if constexpr (FP8) { _Pragma("unroll") for (int m = 0; m < 4; ++m) _Pragma("unroll") for (int n = 0; n < 2; ++n) \
            mfma8(acc[ai][bj][m][n], cat8(Bt[n][0], Bt[n][1]), cat8(At[m][0], At[m][1]), sc1_); } \
        else { _Pragma("unroll") for (int m = 0; m < 4; ++m) _Pragma("unroll") for (int n = 0; n < 2; ++n) _Pragma("unroll") for (int k = 0; k < 2; ++k) \
            acc[ai][bj][m][n] = __builtin_amdgcn_mfma_f32_16x16x32_bf16(Bt[n][k], At[m][k], acc[ai][bj][m][n], 0, 0, 0); } \
        __builtin_amdgcn_s_setprio(0); } while (0)
#define G8_WAIT_V(n) asm volatile("s_waitcnt vmcnt(" #n ")" ::: "memory")
#define G8_WAIT_L(n) asm volatile("s_waitcnt lgkmcnt(" #n ")" ::: "memory")
#define G8_BAR __builtin_amdgcn_s_barrier()
#define G8_SCHED __builtin_amdgcn_sched_barrier(0)
    Unit cur, nxt; int ui = 0;
    if (!S.next(0, cur)) return;
    int sc1_ = 0x7F7F7F7F; asm volatile("" : "+v"(sc1_));
    Acc acc;
#pragma unroll
    for (int a = 0; a < 2; ++a)
#pragma unroll
        for (int b = 0; b < 2; ++b)
#pragma unroll
            for (int m = 0; m < 4; ++m)
#pragma unroll
                for (int n = 0; n < 2; ++n) acc[a][b][m][n] = (f32x4){0.f, 0.f, 0.f, 0.f};
    bf16x8 At[4][2], B0[2][2], B1[2][2];
    const char* cA = G.a_base(cur); const char* cB = G.b_base(cur);
    unsigned c00 = G.a_voff(cur, R0, C0), c01 = G.a_voff(cur, R1, C1), c10 = G.a_voff(cur, R0 + HALF, C0), c11 = G.a_voff(cur, R1 + HALF, C1);
    unsigned n00 = c00, n01 = c01, n10 = c10, n11 = c11;
    G8_STAGE2(G8_SB(0, 0), cB, voffB[0], voffB[1]); G8_STAGE2(G8_SA(0, 0), cA, c00, c01); G8_STAGE2(G8_SB(0, 1), cB + hstep, voffB[0], voffB[1]); G8_STAGE2(G8_SA(0, 1), cA, c10, c11);
    if (wr == 1) G8_BAR;
    G8_WAIT_V(4); G8_BAR;
    G8_STAGE2(G8_SB(1, 0), cB + kstep, voffB[0], voffB[1]); G8_STAGE2(G8_SA(1, 0), cA + kstep, c00, c01); G8_STAGE2(G8_SB(1, 1), cB + hstep + kstep, voffB[0], voffB[1]);
    G8_WAIT_V(6); G8_BAR;
    for (;;) {
        const bool has_next = S.next(ui + 1, nxt);
        const bool hn_ = Sched::HM && cur.hn >= 0;
        const bool sk0_ = Sched::HM && cur.hm <= wr * 64, hm_ = Sched::HM && cur.hm <= 128 + wr * 64;
        const char* nA = has_next ? G.a_base(nxt) : cA; const char* nB = has_next ? G.b_base(nxt) : cB;
        int k00 = 0, k01 = 0, k10 = 0, k11 = 0;
        if constexpr (Ops::GATHER) {
            if (has_next) { k00 = G.a_key(nxt, R0); k01 = G.a_key(nxt, R1); k10 = G.a_key(nxt, R0 + HALF); k11 = G.a_key(nxt, R1 + HALF); }
        }
        for (int t = 0; t < nt; t += 2) {
            const bool last = (t == nt - 2);
            const char* a1 = cA + (size_t)(t + 1) * kstep;
            const char* a2 = last ? nA : cA + (size_t)(t + 2) * kstep; const char* b2 = last ? nB : cB + (size_t)(t + 2) * kstep;
            const char* a3 = a2 + kstep; const char* b3 = b2 + kstep;
            unsigned s00 = c00, s01 = c01, s10 = c10, s11 = c11;
            if constexpr (Ops::GATHER) { if (last) { asm volatile("" : "+v"(k00), "+v"(k01), "+v"(k10), "+v"(k11));
                    if (has_next) { n00 = G.a_off(k00, C0); n01 = G.a_off(k01, C1); n10 = G.a_off(k10, C0); n11 = G.a_off(k11, C1); }
                    else { n00 = c00; n01 = c01; n10 = c10; n11 = c11; }
                    s00 = n00; s01 = n01; s10 = n10; s11 = n11; } }
            if (!sk0_) { G8_LDB(B0, 0, 0); G8_SCHED; G8_LDA(At, 0, 0); }
            G8_STAGE2(G8_SA(1, 1), a1, c10, c11);
            G8_WAIT_L(8); G8_BAR; G8_WAIT_L(0); if (!sk0_) G8_MMA(0, 0, At, B0);
            G8_BAR; G8_SCHED;
            if (!(sk0_ || hn_)) G8_LDB(B1, 0, 1);
            G8_STAGE2(G8_SB(0, 0), b2, voffB[0], voffB[1]);
            G8_BAR; G8_WAIT_L(0); if (!(sk0_ || hn_)) G8_MMA(0, 1, At, B1);
            G8_BAR;
            if (!hm_) G8_LDA(At, 0, 1);
            G8_STAGE2(G8_SA(0, 0), a2, s00, s01);
            G8_BAR; G8_WAIT_L(0); if (!hm_) G8_MMA(1, 0, At, B0);
            G8_BAR; G8_SCHED;
            G8_STAGE2(G8_SB(0, 1), b2 + hstep, voffB[0], voffB[1]);
            G8_WAIT_V(6); G8_BAR; if (!(hm_ || hn_)) G8_MMA(1, 1, At, B1);
            G8_BAR;
            if (!sk0_) { G8_LDB(B0, 1, 0); G8_SCHED; G8_LDA(At, 1, 0); }
            G8_STAGE2(G8_SA(0, 1), a2, s10, s11);
            G8_WAIT_L(8); G8_BAR; G8_WAIT_L(0); if (!sk0_) G8_MMA(0, 0, At, B0);
            G8_BAR; G8_SCHED;
            if (!(sk0_ || hn_)) G8_LDB(B1, 1, 1);
            G8_STAGE2(G8_SB(1, 0), b3, voffB[0], voffB[1]);
            G8_BAR; G8_WAIT_L(0); if (!(sk0_ || hn_)) G8_MMA(0, 1, At, B1);
            G8_BAR;
            if (!hm_) G8_LDA(At, 1, 1);
            G8_STAGE2(G8_SA(1, 0), a3, s00, s01);
            G8_BAR; G8_WAIT_L(0); if (!hm_) G8_MMA(1, 0, At, B0);
            G8_BAR; G8_SCHED;
            G8_STAGE2(G8_SB(1, 1), b3 + hstep, voffB[0], voffB[1]);
            G8_WAIT_V(6); G8_BAR; if (!(hm_ || hn_)) G8_MMA(1, 1, At, B1);
            G8_BAR;
        }
        if constexpr (FP8) {
            asm volatile("s_nop 15\n\ts_nop 15" ::: "memory");
#pragma unroll
            for (int a = 0; a < 2; ++a)
#pragma unroll
                for (int b = 0; b < 2; ++b)
#pragma unroll
                    for (int m = 0; m < 4; ++m) asm volatile("" : "+v"(acc[a][b][m][0]), "+v"(acc[a][b][m][1]));
        }
        E(acc, cur, wr, wc, fr, fq);
        if (!has_next) break;
        if (!E.keep_acc(cur)) {
#pragma unroll
            for (int a = 0; a < 2; ++a)
#pragma unroll
                for (int b = 0; b < 2; ++b)
#pragma unroll
                    for (int m = 0; m < 4; ++m)
#pragma unroll
                        for (int n = 0; n < 2; ++n) acc[a][b][m][n] = (f32x4){0.f, 0.f, 0.f, 0.f};
        }
        cur = nxt; cA = nA; cB = nB; ++ui;
        if (Ops::GATHER) { c00 = n00; c01 = n01; c10 = n10; c11 = n11; }
    }
    G8_WAIT_V(0);
    if (wr == 0) G8_BAR;
    G8_BAR;
#undef G8_SA
#undef G8_SB
#undef G8_STAGE2
#undef G8_LDA
#undef G8_LDB
#undef G8_MMA
#undef G8_WAIT_V
#undef G8_WAIT_L
#undef G8_BAR
#undef G8_SCHED
}

struct OpsPlain {
    static constexpr bool GATHER = false;
    const bf16_t* A; const bf16_t* Bt; int K;
    __device__ __forceinline__ const char* a_base(const Unit& u) const { return (const char*)A + (size_t)u.pm * 256 * K * 2; }
    __device__ __forceinline__ const char* b_base(const Unit& u) const { return (const char*)Bt + (size_t)u.pn * 256 * K * 2; }
    __device__ __forceinline__ unsigned a_voff(const Unit&, int R, int C) const { return (unsigned)(R * K + C) * 2u; }
};
__device__ __forceinline__ void tile_order(int L, int nM, int nN, int& pm, int& pn) {
    const int nwg = nM * nN; int wgid = L;
    { const int q = nwg / 8, r = nwg % 8, xcd = wgid % 8, off = wgid / 8; wgid = (xcd < r ? xcd * (q + 1) : r * (q + 1) + (xcd - r) * q) + off; }
    const int nig = 8 * nN, gid = wgid / nig, fm = gid * 8, gsz = (nM - fm) < 8 ? (nM - fm) : 8;
    pm = fm + ((wgid % nig) % gsz); pn = (wgid % nig) / gsz;
}
}

struct SchedInprojA {
    static constexpr bool HM = false;
    int G, c;
    __device__ __forceinline__ bool next(int i, g8::Unit& u) const {
        const int L = i * G + c; int j;
        u.e = 0; u.mt = 0; u.hm = 256; u.hn = -1;
        if (L < 32 * 9) { g8::tile_order(L, 32, 9, u.pm, j); u.pn = j < 8 ? j : 52; return true; }
        const int Lc = L - 32 * 9;
        if (Lc >= 4 * 5) return false;
        j = Lc >> 2; u.pm = 32 + (Lc & 3); u.pn = j < 4 ? 4 + j : 52;
        return true;
    }
};
struct SchedInprojB {
    static constexpr bool HM = false;
    int G, c;
    __device__ __forceinline__ bool next(int i, g8::Unit& u) const {
        const int L = i * G + c; int j;
        u.e = 0; u.mt = 0; u.hm = 256; u.hn = -1;
        if (L < 32 * 44) { g8::tile_order(L, 32, 44, u.pm, j); u.pn = 8 + j; return true; }
        const int Lc = L - 32 * 44;
        if (Lc >= 4 * 12) return false;
        j = Lc >> 2; u.pm = 32 + (Lc & 3); u.pn = j < 8 ? 8 + j : 24 + j;
        return true;
    }
};
struct OpsPlain8 {
    static constexpr bool GATHER = false;
    const unsigned char* A; const unsigned char* Bt; int pn0;
    __device__ __forceinline__ const char* a_base(const g8::Unit& u) const { return (const char*)A + (size_t)u.pm * 256 * D; }
    __device__ __forceinline__ const char* b_base(const g8::Unit& u) const { return (const char*)Bt + (size_t)(u.pn - pn0) * 256 * D; }
    __device__ __forceinline__ unsigned a_voff(const g8::Unit&, int R, int C) const { return (unsigned)(R * D + C * 2); }
};
template <bool HN>
struct EpiInprojT {
    static constexpr bool PERM = true;
    bf16_t* PM; bf16_t* QR; bf16_t* KR; bf16_t* VV; unsigned char* MG; unsigned char* OG8; float* GATES; const float* bias; float accs;
    const float* g_q; const float* g_k; const float* ROPE; LAS unsigned char* lds;
    __device__ __forceinline__ bool keep_acc(const g8::Unit&) const { return false; }
    __device__ __forceinline__ void operator()(const g8::Acc& acc, const g8::Unit& u, int wr, int wc, int fr, int fq) const {
        const int row0 = u.pm * 256 + wr * 64 + fr, pn = u.pn;
        const int cl0 = wc * 32 + 8 * fq;
        const float* bp = bias + pn * 256 + cl0;
        if (pn == 52) {
            if (wc == 0 && fq < 2) {
                const f32x4 b0 = *(const f32x4*)(bp), b1 = *(const f32x4*)(bp + 4);
#pragma unroll
                for (int ai = 0; ai < 2; ++ai)
#pragma unroll
                    for (int m = 0; m < 4; ++m) {
                        float* gp = GATES + (size_t)(row0 + ai * 128 + m * 16) * 16 + 8 * fq;
                        *(f32x4*)gp = acc[ai][0][m][0] * accs + b0; *(f32x4*)(gp + 4) = acc[ai][0][m][1] * accs + b1;
                    }
            }
            return;
        }
        if constexpr (HN) {
            if (pn >= 24 && pn < 34) {
                const bool isq = pn < 32, lat = u.pm < 32;
                LAS float* xs = (LAS float*)(lds + XS_OFF);
                f32x4 bb[2][2];
#pragma unroll
                for (int bj = 0; bj < 2; ++bj) { bb[bj][0] = *(const f32x4*)(bp + bj * 128); bb[bj][1] = *(const f32x4*)(bp + bj * 128 + 4); }
#pragma unroll
                for (int bj = 0; bj < 2; ++bj)
#pragma unroll
                    for (int ai = 0; ai < 2; ++ai)
#pragma unroll
                        for (int m = 0; m < 4; ++m) {
                            const f32x4 v0 = acc[ai][bj][m][0] * accs + bb[bj][0], v1 = acc[ai][bj][m][1] * accs + bb[bj][1];
                            float ss = v0[0] * v0[0] + v0[1] * v0[1] + v0[2] * v0[2] + v0[3] * v0[3] + v1[0] * v1[0] + v1[1] * v1[1] + v1[2] * v1[2] + v1[3] * v1[3];
                            { auto r_ = __builtin_amdgcn_permlane16_swap(__float_as_uint(ss), __float_as_uint(ss), false, false); ss = __uint_as_float(r_[0]) + __uint_as_float(r_[1]); }
                            { auto r_ = __builtin_amdgcn_permlane32_swap(__float_as_uint(ss), __float_as_uint(ss), false, false); ss = __uint_as_float(r_[0]) + __uint_as_float(r_[1]); }
                            if (fq == 0) xs[(bj * 256 + ai * 128 + wr * 64 + m * 16 + fr) * 4 + wc] = ss;
                        }
                __syncthreads();
                const float* gp = (isq ? g_q : g_k) + cl0;
                const f32x4 gw0 = *(const f32x4*)gp, gw1 = *(const f32x4*)(gp + 4);
#pragma unroll
                for (int ai = 0; ai < 2; ++ai)
#pragma unroll
                    for (int m = 0; m < 4; ++m) {
                        const int row = row0 + ai * 128 + m * 16, rl = ai * 128 + wr * 64 + m * 16 + fr;
                        f32x4 c4 = (f32x4){1.f, 1.f, 1.f, 1.f}, s4 = (f32x4){0.f, 0.f, 0.f, 0.f};
                        int krow;
                        if (lat) {
                            const int t = row & 2047, pos = (cl0 < 64) ? (t >> 6) : (t & 63);
                            const float* rp = ROPE + pos * 32 + ((cl0 >> 1) & 31);
                            c4 = *(const f32x4*)rp; s4 = *(const f32x4*)(rp + 2048);
                            krow = row + (row >> 11) * 256;
                        } else { const int j = row - NLAT; krow = (j >> 8) * KVLEN + TSEQ + (j & 255); }
#pragma unroll
                        for (int bj = 0; bj < 2; ++bj) {
                            const f32x4 tot = *(const LAS f32x4*)(xs + (bj * 256 + rl) * 4);
                            const float rstd = rsqrtf((tot[0] + tot[1] + tot[2] + tot[3]) * (1.f / 128.f) + EPS);
                            const f32x4 y0 = (acc[ai][bj][m][0] * accs + bb[bj][0]) * rstd * gw0, y1 = (acc[ai][bj][m][1] * accs + bb[bj][1]) * rstd * gw1;
                            u32x4 w;
                            w.x = cvt_pk_bf16(y0[0] * c4[0] - y0[1] * s4[0], y0[0] * s4[0] + y0[1] * c4[0]);
                            w.y = cvt_pk_bf16(y0[2] * c4[1] - y0[3] * s4[1], y0[2] * s4[1] + y0[3] * c4[1]);
                            w.z = cvt_pk_bf16(y1[0] * c4[2] - y1[1] * s4[2], y1[0] * s4[2] + y1[1] * c4[2]);
                            w.w = cvt_pk_bf16(y1[2] * c4[3] - y1[3] * s4[3], y1[2] * s4[3] + y1[3] * c4[3]);
                            bf16_t* dp = isq ? QR + (size_t)row * 2048 + (pn - 24) * 256 + bj * 128 + cl0 : KR + (size_t)krow * 512 + (pn - 32) * 256 + bj * 128 + cl0;
                            *(u32x4*)dp = w;
                        }
                    }
                return;
            }
        }
        bf16_t* dst; int ldc; int mode = 0; float scale = 1.f;
        unsigned char* gdst = MG + (pn - 36) * 256; int gld = 4096;
        if (pn >= 16 && pn < 24) { dst = PM; ldc = 0; mode = 1; gdst = OG8 + (pn - 16) * 256; gld = 2048; }
        else if (pn < 24) { dst = PM + pn * 256; ldc = 6144; if (pn < 4) scale = 0.0625f; }
                else if (pn < 36) { dst = VV + (pn - 34) * 256; ldc = 512; mode = 2; }
        else { dst = PM; ldc = 0; mode = 1; }
        int rowadd = 0;
        if (mode == 2) rowadd = (u.pm < 32) ? (u.pm >> 3) * 256 : (-6144 + 2048 * (u.pm - 32));
#pragma unroll
        for (int bj = 0; bj < 2; ++bj) {
            const f32x4 b0 = *(const f32x4*)(bp + bj * 128), b1 = *(const f32x4*)(bp + bj * 128 + 4);
#pragma unroll
            for (int ai = 0; ai < 2; ++ai)
#pragma unroll
                for (int m = 0; m < 4; ++m) {
                    f32x4 v0 = (acc[ai][bj][m][0] * accs + b0) * scale, v1 = (acc[ai][bj][m][1] * accs + b1) * scale;
                    if (mode == 1) {
                        unsigned q0 = 0u, q1 = 0u;
#pragma unroll
                        for (int j = 0; j < 4; ++j) {
                            q0 = __builtin_amdgcn_cvt_pk_u8_f32(fmaxf(sigmoidf_(v0[j]) * 255.f, 1.f), j, q0);
                            q1 = __builtin_amdgcn_cvt_pk_u8_f32(fmaxf(sigmoidf_(v1[j]) * 255.f, 1.f), j, q1);
                        }
                        *(u32x2*)(gdst + (size_t)(row0 + ai * 128 + m * 16) * gld + bj * 128 + cl0) = (u32x2){q0, q1};
                        continue;
                    }
                    u32x4 w; w.x = cvt_pk_bf16(v0[0], v0[1]); w.y = cvt_pk_bf16(v0[2], v0[3]); w.z = cvt_pk_bf16(v1[0], v1[1]); w.w = cvt_pk_bf16(v1[2], v1[3]);
                    *(u32x4*)(dst + (size_t)(row0 + ai * 128 + m * 16 + rowadd) * ldc + bj * 128 + cl0) = w;
                }
        }
    }
};

struct SchedDual {
    static constexpr bool HM = false;
    int G, c;
    __device__ __forceinline__ bool next(int i, g8::Unit& u) const {
        const int L = (i >> 1) * G + c;
        if (L >= 256) return false;
        g8::tile_order(L, 32, 8, u.pm, u.pn); u.e = i & 1; u.mt = 0; u.hm = 256; u.hn = -1; return true;
    }
};
constexpr float AO_SCALE = 8.f, MRG_SCALE = 4.f;
struct OpsDual {
    static constexpr bool GATHER = false;
    const unsigned char* A0; const unsigned char* A1; const unsigned char* B0; const unsigned char* B1;
    __device__ __forceinline__ const char* a_base(const g8::Unit& u) const { return (const char*)(u.e ? A1 : A0) + (size_t)u.pm * 256 * D; }
    __device__ __forceinline__ const char* b_base(const g8::Unit& u) const { return (const char*)(u.e ? B1 : B0) + (size_t)u.pn * 256 * D; }
    __device__ __forceinline__ unsigned a_voff(const g8::Unit&, int R, int C) const { return (unsigned)(R * D + C * 2); }
};
struct EpiMerge {
    static constexpr bool PERM = true;
    const unsigned char* MG; unsigned char* OUT;
    __device__ __forceinline__ bool keep_acc(const g8::Unit& u) const { return u.e == 0; }
    __device__ __forceinline__ void operator()(g8::Acc& acc, const g8::Unit& u, int wr, int wc, int fr, int fq) const {
        const int row0 = u.pm * 256 + wr * 64 + fr, col0 = u.pn * 256 + wc * 32 + 8 * fq;
        constexpr float FS = MRG_SCALE / (WSCALE * AO_SCALE * 255.f);
#define UB4(x) (f32x4){(float)((x) & 0xffu), (float)(((x) >> 8) & 0xffu), (float)(((x) >> 16) & 0xffu), (float)((x) >> 24)}
#pragma unroll
        for (int ai = 0; ai < 2; ++ai) {
            u32x2 ga[4][2], gm[4][2];
#pragma unroll
            for (int m = 0; m < 4; ++m)
#pragma unroll
                for (int bj = 0; bj < 2; ++bj) {
                    const unsigned char* gp = MG + (size_t)(row0 + ai * 128 + m * 16) * 4096 + col0 + bj * 128;
                    ga[m][bj] = *(const u32x2*)(gp + 2048);
                    if (u.e == 0) gm[m][bj] = *(const u32x2*)gp;
                }
#pragma unroll
            for (int m = 0; m < 4; ++m) {
                const size_t row = (size_t)(row0 + ai * 128 + m * 16);
#pragma unroll
                for (int bj = 0; bj < 2; ++bj) {
                    const int col = col0 + bj * 128;
                    const f32x4 a0 = UB4(ga[m][bj].x), a1 = UB4(ga[m][bj].y);
                    if (u.e == 0) {
                        const f32x4 g0 = UB4(gm[m][bj].x), g1 = UB4(gm[m][bj].y);
                        f32x4 r0, r1;
#pragma unroll
                        for (int j = 0; j < 4; ++j) { r0[j] = g0[j] * __builtin_amdgcn_rcpf(a0[j]); r1[j] = g1[j] * __builtin_amdgcn_rcpf(a1[j]); }
                        acc[ai][bj][m][0] *= r0 * AO_SCALE; acc[ai][bj][m][1] *= r1 * AO_SCALE;
                    } else {
                        const f32x4 v0 = acc[ai][bj][m][0] * FS * a0, v1 = acc[ai][bj][m][1] * FS * a1;
                        u32x2 w; w.x = pk4_fp8(v0[0], v0[1], v0[2], v0[3]); w.y = pk4_fp8(v1[0], v1[1], v1[2], v1[3]);
                        *(u32x2*)(OUT + row * 2048 + col) = w;
                    }
                }
            }
        }
#undef UB4
    }
};

struct SchedSquare {
    static constexpr bool HM = false;
    int G, c, nM, nN;
    __device__ __forceinline__ bool next(int i, g8::Unit& u) const {
        const int L = i * G + c;
        if (L >= nM * nN) return false;
        g8::tile_order(L, nM, nN, u.pm, u.pn); u.e = 0; u.mt = 0; u.hm = 256; u.hn = -1; return true;
    }
};
struct EpiOut {
    static constexpr bool PERM = true;
    const float* X; const float* MOD; bf16_t* HX; float accs;
    __device__ __forceinline__ bool keep_acc(const g8::Unit&) const { return false; }
    __device__ __forceinline__ void operator()(const g8::Acc& acc, const g8::Unit& u, int wr, int wc, int fr, int fq) const {
        const int row0 = u.pm * 256 + wr * 64 + fr, col0 = u.pn * 256 + wc * 32 + 8 * fq;
        const float* gt = MOD + (size_t)(u.pm >> 3) * 12288 + 4096 + col0;
        f32x4 g[2][2];
#pragma unroll
        for (int bj = 0; bj < 2; ++bj)
#pragma unroll
            for (int n = 0; n < 2; ++n) g[bj][n] = *(const f32x4*)(gt + bj * 128 + n * 4) * accs;
#pragma unroll
        for (int ai = 0; ai < 2; ++ai) {
            f32x4 xv[4][2][2];
#pragma unroll
            for (int m = 0; m < 4; ++m) {
                const size_t ro = (size_t)(row0 + ai * 128 + m * 16) * 2048 + col0;
#pragma unroll
                for (int bj = 0; bj < 2; ++bj)
#pragma unroll
                    for (int n = 0; n < 2; ++n) xv[m][bj][n] = *(const f32x4*)(X + ro + bj * 128 + n * 4);
            }
#pragma unroll
            for (int m = 0; m < 4; ++m) {
                const size_t ro = (size_t)(row0 + ai * 128 + m * 16) * 2048 + col0;
#pragma unroll
                for (int bj = 0; bj < 2; ++bj) {
                    const f32x4 v0 = xv[m][bj][0] + g[bj][0] * acc[ai][bj][m][0], v1 = xv[m][bj][1] + g[bj][1] * acc[ai][bj][m][1];
                    u32x4 w; w.x = cvt_pk_bf16(v0[0], v0[1]); w.y = cvt_pk_bf16(v0[2], v0[3]); w.z = cvt_pk_bf16(v1[0], v1[1]); w.w = cvt_pk_bf16(v1[2], v1[3]);
                    *(u32x4*)(HX + ro + bj * 128) = w;
                }
            }
        }
    }
};

struct SchedMoe {
    static constexpr bool HM = true;
    int G, vcu, NT; const volatile LAS int* mstart; const volatile LAS int* texp; const volatile LAS int* ecnt; int split;
    __device__ __forceinline__ bool next(int i, g8::Unit& u) const {
        const int total = mstart[32] * NT;
        int L = i * G + vcu, hn = -1;
        if (split) {
            const int R = total / G, r = total - R * G;
            if (r > 0 && 2 * r <= G && i >= R) { if (i > R || vcu >= 2 * r) return false; L = R * G + (vcu >> 1); hn = vcu & 1; }
        }
        if (L >= total) return false;
        u.hn = hn;
        const int mg = L / NT;
        const int e = texp[mg];
        const int ms = mstart[e], nm = mstart[e + 1] - ms, local = L - ms * NT;
        u.e = e; u.mt = local % nm; u.pn = local / nm; u.pm = ms + u.mt;
        { const int left = ecnt[e] - u.mt * 256; u.hm = left < 256 ? left : 256; }
        return true;
    }
};
struct OpsMoe1 {
    static constexpr bool GATHER = true;
    const unsigned char* U2; const unsigned char* WT; const int* LIST; const volatile LAS int* ecnt;
    __device__ __forceinline__ const char* a_base(const g8::Unit&) const { return (const char*)U2; }
    __device__ __forceinline__ const char* b_base(const g8::Unit& u) const { return (const char*)WT + ((size_t)u.e * 4096 + (size_t)u.pn * 256) * D; }
    __device__ __forceinline__ int a_key(const g8::Unit& u, int R) const {
        const int n = ecnt[u.e]; int slot = u.mt * 256 + R; slot = slot < n ? slot : n - 1;
        return LIST[u.e * NLAT + slot];
    }
    __device__ __forceinline__ unsigned a_off(int tok, int C) const { return (unsigned)(tok * D + C * 2); }
    __device__ __forceinline__ unsigned a_voff(const g8::Unit& u, int R, int C) const { return a_off(a_key(u, R), C); }
};
struct EpiMoe1 {
    static constexpr bool PERM = true;
    unsigned char* HID; const float* bgu;
    __device__ __forceinline__ bool keep_acc(const g8::Unit&) const { return false; }
    __device__ __forceinline__ void operator()(const g8::Acc& acc, const g8::Unit& u, int wr, int wc, int fr, int fq) const {
        const int row0 = u.pm * 256 + wr * 64 + fr, j0 = u.pn * 128 + wc * 32 + 8 * fq;
        const float* bg = bgu + (size_t)u.e * 4096 + j0; const float* bu = bg + 2048;
        const f32x4 g0 = *(const f32x4*)bg, g1 = *(const f32x4*)(bg + 4), u0 = *(const f32x4*)bu, u1 = *(const f32x4*)(bu + 4);
#pragma unroll
        for (int ai = 0; ai < 2; ++ai) {
            if (u.hm <= ai * 128 + wr * 64) break;
#pragma unroll
            for (int m = 0; m < 4; ++m) {
                f32x4 ga = acc[ai][0][m][0] * WINV + g0, gb = acc[ai][0][m][1] * WINV + g1, ua = acc[ai][1][m][0] * WINV + u0, ub = acc[ai][1][m][1] * WINV + u1;
                f32x4 ha, hb;
#pragma unroll
                for (int j = 0; j < 4; ++j) {
                    const float gt = fminf(ga[j], 7.f), up = fminf(fmaxf(ua[j], -7.f), 7.f);
                    ha[j] = (up + 1.f) * gt * sigmoidf_(1.702f * gt);
                    const float gt2 = fminf(gb[j], 7.f), up2 = fminf(fmaxf(ub[j], -7.f), 7.f);
                    hb[j] = (up2 + 1.f) * gt2 * sigmoidf_(1.702f * gt2);
                }
                u32x2 w; w.x = pk4_fp8(ha[0], ha[1], ha[2], ha[3]); w.y = pk4_fp8(hb[0], hb[1], hb[2], hb[3]);
                *(u32x2*)(HID + (size_t)(row0 + ai * 128 + m * 16) * 2048 + j0) = w;
            }
        }
    }
};
struct OpsMoe2 {
    static constexpr bool GATHER = false;
    const unsigned char* HID; const unsigned char* WT;
    __device__ __forceinline__ const char* a_base(const g8::Unit& u) const { return (const char*)HID + (size_t)u.pm * 256 * D; }
    __device__ __forceinline__ const char* b_base(const g8::Unit& u) const { return (const char*)WT + ((size_t)u.e * 2048 + (size_t)u.pn * 256 + (u.hn > 0 ? 128 : 0)) * D; }
    __device__ __forceinline__ unsigned a_voff(const g8::Unit&, int R, int C) const { return (unsigned)(R * D + C * 2); }
};
struct EpiMoe2 {
    static constexpr bool PERM = true;
    bf16_t* Y; const float* bdn;
    __device__ __forceinline__ bool keep_acc(const g8::Unit&) const { return false; }
    __device__ __forceinline__ void operator()(const g8::Acc& acc, const g8::Unit& u, int wr, int wc, int fr, int fq) const {
        const int row0 = u.pm * 256 + wr * 64 + fr, col0 = u.pn * 256 + (u.hn > 0 ? 128 : 0) + wc * 32 + 8 * fq;
        const float* bp = bdn + (size_t)u.e * 2048 + col0;
#pragma unroll
        for (int bj = 0; bj < 2; ++bj) {
            if (bj == 1 && u.hn >= 0) break;
            const f32x4 b0 = *(const f32x4*)(bp + bj * 128), b1 = *(const f32x4*)(bp + bj * 128 + 4);
#pragma unroll
            for (int ai = 0; ai < 2; ++ai) {
                if (u.hm <= ai * 128 + wr * 64) break;
#pragma unroll
                for (int m = 0; m < 4; ++m) {
                    const f32x4 v0 = acc[ai][bj][m][0] * WINV + b0, v1 = acc[ai][bj][m][1] * WINV + b1;
                    u32x4 w; w.x = cvt_pk_bf16(v0[0], v0[1]); w.y = cvt_pk_bf16(v0[2], v0[3]); w.z = cvt_pk_bf16(v1[0], v1[1]); w.w = cvt_pk_bf16(v1[2], v1[3]);
                    *(u32x4*)(Y + (size_t)(row0 + ai * 128 + m * 16) * 2048 + col0 + bj * 128) = w;
                }
            }
        }
    }
};

namespace att {
constexpr int DH = 128, NW = 8, QBLK = 32, KVBLK = 64;
constexpr float SCALE = 0.088388347648318440f;
constexpr float THR = 8.f;
constexpr int LDQ = 2048, LDK = 512, LDO = 2048;
constexpr size_t SHM_V = KVBLK * DH * 2, SHM_K = KVBLK * DH * 2;
#define KSWZ(row, colB) ((row) * 256 + ((colB) ^ (((row) & 7) << 4)))
#define SBAR() __builtin_amdgcn_sched_barrier(0)
__device__ __forceinline__ int crow(int r, int hi) { return (r & 3) + 8 * (r >> 2) + 4 * hi; }
__device__ __forceinline__ void partialSM(f32x16& p0, f32x16& p1, float& m_reg, float& mn, float& alpha) {
  constexpr float C = SCALE * 1.4426950408889634f;
  float pmax = p0[0];
#pragma unroll
  for (int r = 1; r < 16; ++r) pmax = fmaxf(pmax, p0[r]);
#pragma unroll
  for (int r = 0; r < 16; ++r) pmax = fmaxf(pmax, p1[r]);
  { auto rr = __builtin_amdgcn_permlane32_swap(__float_as_uint(pmax), __float_as_uint(pmax), false, false);
    pmax = fmaxf(__uint_as_float(rr[0]), __uint_as_float(rr[1])); }
  if (__builtin_expect(__all(pmax - m_reg <= THR / SCALE), 1)) { mn = m_reg; alpha = 1.f; }
  else { mn = fmaxf(m_reg, pmax); alpha = __builtin_amdgcn_exp2f((m_reg - mn) * C); m_reg = mn; }
  float mnC = -mn * C;
#pragma unroll
  for (int r = 0; r < 16; ++r) p0[r] = fmaf(p0[r], C, mnC);
#pragma unroll
  for (int r = 0; r < 16; ++r) p1[r] = fmaf(p1[r], C, mnC);
#pragma unroll
  for (int r = 0; r < 16; ++r) p0[r] = __builtin_amdgcn_exp2f(p0[r]);
}
__device__ __forceinline__ void finishSM(f32x16& p0, f32x16& p1, float alpha, float& l_reg, bf16x8& pa0, bf16x8& pa1, bf16x8& pa2, bf16x8& pa3) {
#pragma unroll
  for (int r = 0; r < 16; ++r) p1[r] = __builtin_amdgcn_exp2f(p1[r]);
  float ps = 0;
#pragma unroll
  for (int r = 0; r < 16; ++r) ps += p0[r];
#pragma unroll
  for (int r = 0; r < 16; ++r) ps += p1[r];
  { auto rr = __builtin_amdgcn_permlane32_swap(__float_as_uint(ps), __float_as_uint(ps), false, false);
    ps = __uint_as_float(rr[0]) + __uint_as_float(rr[1]); }
  l_reg = l_reg * alpha + ps;
#define PK4(P, BASE, OUT) do { unsigned a0 = cvt_pk_bf16(P[BASE + 0], P[BASE + 1]), a1 = cvt_pk_bf16(P[BASE + 2], P[BASE + 3]);   \
    unsigned b0 = cvt_pk_bf16(P[BASE + 4], P[BASE + 5]), b1 = cvt_pk_bf16(P[BASE + 6], P[BASE + 7]);                              \
    auto r0 = __builtin_amdgcn_permlane32_swap(a0, b0, false, false); auto r1 = __builtin_amdgcn_permlane32_swap(a1, b1, false, false); \
    u32x4 w = {r0[0], r1[0], r0[1], r1[1]}; OUT = *reinterpret_cast<bf16x8*>(&w); } while (0)
  PK4(p0, 0, pa0); PK4(p0, 8, pa1); PK4(p1, 0, pa2); PK4(p1, 8, pa3);
#undef PK4
}
__device__ __forceinline__ void qkt(f32x16& p0, f32x16& p1, const bf16_t* Ks, const bf16x8* qr, int r32, int hi) {
  p0 = f32x16{}; p1 = f32x16{};
#pragma unroll
  for (int d0 = 0; d0 < 8; ++d0) { int cb = (d0 * 16 + hi * 8) * 2;
    bf16x8 b0 = *reinterpret_cast<const bf16x8*>((const char*)Ks + KSWZ(r32, cb));
    bf16x8 b1 = *reinterpret_cast<const bf16x8*>((const char*)Ks + KSWZ(32 + r32, cb));
    p0 = __builtin_amdgcn_mfma_f32_32x32x16_bf16(b0, qr[d0], p0, 0, 0, 0);
    p1 = __builtin_amdgcn_mfma_f32_32x32x16_bf16(b1, qr[d0], p1, 0, 0, 0); }
}
__device__ __forceinline__ int v_st(int k, int c) { const int kk = (k & ~0xC) | ((k & 4) << 1) | ((k & 8) >> 1); return ((kk >> 3) * 4 + (c >> 5)) * 512 + ((kk & 7) * 32 + (c & 31)) * 2; }
__device__ __forceinline__ int v_rd_base(int lane) { return ((lane & 3) << 3) | (((lane >> 2) & 3) << 6) | (((lane >> 4) & 1) << 5) | (((lane >> 5) & 1) << 8); }
constexpr int v_rd_off(int d0, int ks, int half) { return d0 * 512 + ks * 4096 + half * 2048; }
template <int OFF> __device__ __forceinline__ s16x4 tr_read(int vb) {
  s16x4 r; asm volatile("ds_read_b64_tr_b16 %0, %1 offset:%2" : "=&v"(r) : "v"(vb), "i"(OFF) : "memory"); return r;
}
template <int D0> __device__ __forceinline__ void pv_one(f32x16& od, int vb, bf16x8 pa0, bf16x8 pa1, bf16x8 pa2, bf16x8 pa3) {
  const s16x4 l0 = tr_read<v_rd_off(D0, 0, 0)>(vb), h0 = tr_read<v_rd_off(D0, 0, 1)>(vb), l1 = tr_read<v_rd_off(D0, 1, 0)>(vb), h1 = tr_read<v_rd_off(D0, 1, 1)>(vb);
  const s16x4 l2 = tr_read<v_rd_off(D0, 2, 0)>(vb), h2 = tr_read<v_rd_off(D0, 2, 1)>(vb), l3 = tr_read<v_rd_off(D0, 3, 0)>(vb), h3 = tr_read<v_rd_off(D0, 3, 1)>(vb);
  asm volatile("s_waitcnt lgkmcnt(0)" ::: "memory"); SBAR();
#define PK(L, H) (bf16x8){L[0], L[1], L[2], L[3], H[0], H[1], H[2], H[3]}
  od = __builtin_amdgcn_mfma_f32_32x32x16_bf16(pa0, PK(l0, h0), od, 0, 0, 0);
  od = __builtin_amdgcn_mfma_f32_32x32x16_bf16(pa1, PK(l1, h1), od, 0, 0, 0);
  od = __builtin_amdgcn_mfma_f32_32x32x16_bf16(pa2, PK(l2, h2), od, 0, 0, 0);
  od = __builtin_amdgcn_mfma_f32_32x32x16_bf16(pa3, PK(l3, h3), od, 0, 0, 0);
#undef PK
}
__device__ __forceinline__ void pv_d0(f32x16* o, int vb, bf16x8 pa0, bf16x8 pa1, bf16x8 pa2, bf16x8 pa3) {
  pv_one<0>(o[0], vb, pa0, pa1, pa2, pa3); pv_one<1>(o[1], vb, pa0, pa1, pa2, pa3); pv_one<2>(o[2], vb, pa0, pa1, pa2, pa3); pv_one<3>(o[3], vb, pa0, pa1, pa2, pa3);
}
__device__ __forceinline__ void attn_dense_body(const bf16_t* __restrict__ Qb, const bf16_t* __restrict__ Kh, const bf16_t* __restrict__ Vh,
                                                unsigned char* __restrict__ Ob, int seq, char* lds, LAS unsigned char* lds3, const int wave_) {
  const int wid = wave_, lane = lane_id_(), tid = wid * 64 + lane, r32 = lane & 31, hi = lane >> 5;
  bf16_t* V_lds = (bf16_t*)lds; bf16_t* K_lds = (bf16_t*)(lds + 2 * SHM_V);
  float* ws = (float*)(lds + 2 * SHM_V + 2 * SHM_K) + wid * 64; float* li_l = ws; float* al_l = ws + 32;
  float m_reg = -1e30f, l_reg = 0; f32x16 o[4] = {}; bf16x8 qr[8];
  const bf16_t* Qw = Qb + (long)(wid * QBLK + r32) * LDQ + hi * 8;
#pragma unroll
  for (int d0 = 0; d0 < 8; ++d0) qr[d0] = *reinterpret_cast<const bf16x8*>(Qw + d0 * 16);
  const int sr = tid >> 4, sc = (tid & 15) * 8, vst0 = v_st(sr, sc), vst1 = v_st(32 + sr, sc);
  const int vb0 = (int)(uintptr_t)V_lds + v_rd_base(lane);
  struct { bf16x8 vs0, vs1, ks0, ks1; } sr_[2];
#define SLOAD(i, k0) do { sr_[i].vs0 = *reinterpret_cast<const bf16x8*>(&Vh[(long)((k0) + sr) * LDK + sc]); sr_[i].vs1 = *reinterpret_cast<const bf16x8*>(&Vh[(long)((k0) + 32 + sr) * LDK + sc]); \
    sr_[i].ks0 = *reinterpret_cast<const bf16x8*>(&Kh[(long)((k0) + sr) * LDK + sc]); sr_[i].ks1 = *reinterpret_cast<const bf16x8*>(&Kh[(long)((k0) + 32 + sr) * LDK + sc]); } while (0)
#define SWRITE(b, i) do { *(bf16x8*)((char*)V_lds + (b) * SHM_V + vst0) = sr_[i].vs0;          \
    *(bf16x8*)((char*)V_lds + (b) * SHM_V + vst1) = sr_[i].vs1; int kc = sc * 2;               \
    *(bf16x8*)((char*)K_lds + (b) * SHM_K + KSWZ(sr, kc)) = sr_[i].ks0;                       \
    *(bf16x8*)((char*)K_lds + (b) * SHM_K + KSWZ(32 + sr, kc)) = sr_[i].ks1; } while (0)
#define SWAIT() do { asm volatile("s_waitcnt vmcnt(4)" ::: "memory"); } while (0)
#define RESC(a) do { if (__any((a) < 1.f)) { if (hi == 0) al_l[r32] = (a); asm volatile("s_waitcnt lgkmcnt(0)" ::: "memory"); \
    _Pragma("unroll") for (int d = 0; d < 4; ++d) _Pragma("unroll") for (int r = 0; r < 16; ++r) o[d][r] *= al_l[crow(r, hi)]; } } while (0)
  f32x16 pA0, pA1, pB0, pB1; float mnA, mnB, alA, alB; bf16x8 pa0, pa1, pa2, pa3; const int NT = seq / KVBLK;
  constexpr int SE = 0, SO = 1;
  SLOAD(SE, 0); asm volatile("s_waitcnt vmcnt(0)" ::: "memory"); SWRITE(0, SE); __syncthreads();
  qkt(pA0, pA1, K_lds, qr, r32, hi); partialSM(pA0, pA1, m_reg, mnA, alA);
  SLOAD(SO, KVBLK); if (2 < NT) SLOAD(SE, 2 * KVBLK);
  SWAIT(); SWRITE(1, SO); __syncthreads();
  for (int j = 1; j + 1 < NT; j += 2) {
    SBAR(); qkt(pB0, pB1, (bf16_t*)((char*)K_lds + SHM_K), qr, r32, hi);
    finishSM(pA0, pA1, alA, l_reg, pa0, pa1, pa2, pa3); SBAR();
    SLOAD(SO, (j + 2) * KVBLK); SBAR();
    pv_d0(o, vb0, pa0, pa1, pa2, pa3); partialSM(pB0, pB1, m_reg, mnB, alB);
    __syncthreads(); SWAIT(); SWRITE(0, SE);
    RESC(alB); __syncthreads();
    SBAR(); qkt(pA0, pA1, K_lds, qr, r32, hi);
    finishSM(pB0, pB1, alB, l_reg, pa0, pa1, pa2, pa3); SBAR();
    if (j + 3 < NT) SLOAD(SE, (j + 3) * KVBLK); SBAR();
    pv_d0(o, vb0 + (int)SHM_V, pa0, pa1, pa2, pa3); partialSM(pA0, pA1, m_reg, mnA, alA);
    __syncthreads(); SWAIT(); SWRITE(1, SO);
    RESC(alA); __syncthreads();
  }
  SBAR(); qkt(pB0, pB1, (bf16_t*)((char*)K_lds + SHM_K), qr, r32, hi);
  finishSM(pA0, pA1, alA, l_reg, pa0, pa1, pa2, pa3); SBAR();
  pv_d0(o, vb0, pa0, pa1, pa2, pa3); partialSM(pB0, pB1, m_reg, mnB, alB);
  __syncthreads(); RESC(alB);
  finishSM(pB0, pB1, alB, l_reg, pa0, pa1, pa2, pa3); SBAR();
  pv_d0(o, vb0 + (int)SHM_V, pa0, pa1, pa2, pa3);
  if (hi == 0) li_l[r32] = l_reg; asm volatile("s_waitcnt lgkmcnt(0)" ::: "memory");
  float rli[16];
#pragma unroll
  for (int r = 0; r < 16; ++r) rli[r] = __builtin_amdgcn_rcpf(li_l[crow(r, hi)]);
  LAS unsigned char* stg = lds3 + 68 * 1024 + wid * 8192;
#pragma unroll
  for (int r = 0; r < 16; ++r) { const int orow = crow(r, hi);
#pragma unroll
    for (int d0 = 0; d0 < 4; ++d0) *(LAS unsigned short*)(stg + orow * 256 + (d0 * 32 + r32) * 2) = (unsigned short)(cvt_pk_bf16(o[d0][r] * rli[r], 0.f) & 0xffffu); }
  unsigned char* Ow = Ob + (long)(wid * QBLK) * LDO;
#pragma unroll
  for (int j = 0; j < 4; ++j) {
    const int idx = lane + 64 * j, orow = idx >> 3, ch = idx & 7;
    const u32x4 a = *(const LAS u32x4*)(stg + orow * 256 + ch * 32), b = *(const LAS u32x4*)(stg + orow * 256 + ch * 32 + 16);
    u32x4 w;
    w.x = pk4_fp8(bf_lo(a.x) * AO_SCALE, bf_hi(a.x) * AO_SCALE, bf_lo(a.y) * AO_SCALE, bf_hi(a.y) * AO_SCALE); w.y = pk4_fp8(bf_lo(a.z) * AO_SCALE, bf_hi(a.z) * AO_SCALE, bf_lo(a.w) * AO_SCALE, bf_hi(a.w) * AO_SCALE);
    w.z = pk4_fp8(bf_lo(b.x) * AO_SCALE, bf_hi(b.x) * AO_SCALE, bf_lo(b.y) * AO_SCALE, bf_hi(b.y) * AO_SCALE); w.w = pk4_fp8(bf_lo(b.z) * AO_SCALE, bf_hi(b.z) * AO_SCALE, bf_lo(b.w) * AO_SCALE, bf_hi(b.w) * AO_SCALE);
    *(u32x4*)(Ow + (long)orow * LDO + ch * 16) = w;
  }
  __syncthreads();
#undef SLOAD
#undef SWRITE
#undef SWAIT
#undef RESC
}
}

namespace ml {
constexpr int QS = 0, KS = 33792, VS = 67584, VWS = 76800, SS = 86016, CTS = 95232, NV = 129024;
constexpr int SC_A = 130048, SC_M = SC_A + 256, SC_WI = SC_M + 256, SC_TH = SC_WI + 256, SC_WS = SC_TH + 256, SC_DEN = SC_WS + 256, SC_WC = SC_DEN + 256, NV2 = SC_WC + 256;
constexpr int RQ = 528, RV = 144;

__device__ __forceinline__ bf16x8 tr_pair(const LAS unsigned char* p, int rowstride4) {
    const s16x4 lo = __builtin_amdgcn_ds_read_tr16_b64_v4i16((LAS s16x4*)p);
    const s16x4 hi = __builtin_amdgcn_ds_read_tr16_b64_v4i16((LAS s16x4*)(p + rowstride4));
    return (bf16x8){lo[0], lo[1], lo[2], lo[3], hi[0], hi[1], hi[2], hi[3]};
}

struct Conv { const float* w_gu; const float* w_dn; unsigned char* WTGU; unsigned char* WTDN; int t, nw; };
constexpr int T_GU = NE * 16 * 128, T_DN = NE * 16 * 64, T_CONV = T_GU + T_DN;
#define CV_ISSUE() do { if (cvs.t < T_CONV) { const float* sp_; \
        if (cvs.t < T_GU) { const int e_ = cvs.t >> 11, r_ = cvs.t & 2047, nb_ = r_ & 127, kb_ = r_ >> 7; sp_ = cvs.w_gu + (size_t)e_ * 2048 * 4096 + (size_t)(kb_ * 128 + (lane >> 3) * 16) * 4096 + nb_ * 32 + (lane & 7) * 4; \
            _Pragma("unroll") for (int kk = 0; kk < 16; ++kk) cv[kk] = __builtin_nontemporal_load((const f32x4*)(sp_ + (size_t)kk * 4096)); } \
        else { const int q_ = cvs.t - T_GU, e_ = q_ >> 10, r_ = q_ & 1023, nb_ = r_ & 63, kb_ = r_ >> 6; sp_ = cvs.w_dn + (size_t)e_ * 2048 * 2048 + (size_t)(kb_ * 128 + (lane >> 3) * 16) * 2048 + nb_ * 32 + (lane & 7) * 4; \
            _Pragma("unroll") for (int kk = 0; kk < 16; ++kk) cv[kk] = __builtin_nontemporal_load((const f32x4*)(sp_ + (size_t)kk * 2048)); } } } while (0)
#define CV_FINISH() do { if (cvs.t < T_CONV) { unsigned char* dp_; \
        if (cvs.t < T_GU) { const int e_ = cvs.t >> 11, r_ = cvs.t & 2047, nb_ = r_ & 127, kb_ = r_ >> 7, n_ = nb_ * 32 + (lane & 7) * 4, j_ = n_ & 2047, nd_ = (j_ >> 7) * 256 + ((n_ >> 11) << 7) + (j_ & 127); \
            dp_ = cvs.WTGU + ((size_t)e_ * 4096 + nd_) * D + kb_ * 128 + (lane >> 3) * 16; } \
        else { const int q_ = cvs.t - T_GU, e_ = q_ >> 10, r_ = q_ & 1023, nb_ = r_ & 63, kb_ = r_ >> 6, n_ = nb_ * 32 + (lane & 7) * 4; \
            dp_ = cvs.WTDN + ((size_t)e_ * 2048 + n_) * D + kb_ * 128 + (lane >> 3) * 16; } \
        _Pragma("unroll") for (int j = 0; j < 4; ++j) { u32x4 w_; \
            w_.x = pk4_fp8(cv[0][j] * WSCALE, cv[1][j] * WSCALE, cv[2][j] * WSCALE, cv[3][j] * WSCALE); \
            w_.y = pk4_fp8(cv[4][j] * WSCALE, cv[5][j] * WSCALE, cv[6][j] * WSCALE, cv[7][j] * WSCALE); \
            w_.z = pk4_fp8(cv[8][j] * WSCALE, cv[9][j] * WSCALE, cv[10][j] * WSCALE, cv[11][j] * WSCALE); \
            w_.w = pk4_fp8(cv[12][j] * WSCALE, cv[13][j] * WSCALE, cv[14][j] * WSCALE, cv[15][j] * WSCALE); \
            *(u32x4*)(dp_ + (size_t)j * D) = w_; } } cvs.t += cvs.nw; } while (0)

__device__ __forceinline__ void mlstm_unit(LAS unsigned char* lds, const bf16_t* __restrict__ PM, const float* __restrict__ GATES, bf16_t* __restrict__ Hout,
                                           int b, int h, int dir, int vs, Conv& cvs, const int wave_) {
    f32x4 cv[16];
    const int w = wave_, lane = lane_id_(), tid = w * 64 + lane, g = lane >> 4, i16 = lane & 15, q4 = i16 >> 2, p4 = lane & 3;
    const int sr = tid >> 3, c8 = tid & 7;
    f32x4 accC[2][4];
#pragma unroll
    for (int a = 0; a < 2; ++a)
#pragma unroll
        for (int v = 0; v < 4; ++v) accC[a][v] = (f32x4){0.f, 0.f, 0.f, 0.f};
    if (tid < 256) *(LAS float*)(lds + NV + tid * 4) = 0.f;
    float m_in = 0.f;
    bool pend_b = false;
    u32x4 rq[4], rk[4], rv; float g_i = 0.f, g_f = 0.f;
    const int gi_col = (dir ? 8 : 0) + h, gf_col = (dir ? 12 : 4) + h;
#define ML_ROW0(ci) ((ci) < 4 ? (NLAT + b * NCTXB + (dir ? (NCTXB - 64 * ((ci) + 1)) : 64 * (ci))) : (b * TSEQ + (dir ? (TSEQ - 64 * ((ci) - 3)) : 64 * ((ci) - 4))))
#define ML_LOAD(ci) do { const int _r0 = ML_ROW0(ci); const bf16_t* _rp = PM + (size_t)(_r0 + sr) * 6144; \
        _Pragma("unroll") for (int j = 0; j < 4; ++j) rk[j] = *(const u32x4*)(_rp + 1024 + h * 256 + (j * 8 + c8) * 8); \
        rv = *(const u32x4*)(_rp + 2048 + h * 512 + vs * 64 + c8 * 8); \
        if ((ci) >= 4) { _Pragma("unroll") for (int j = 0; j < 4; ++j) rq[j] = *(const u32x4*)(_rp + h * 256 + (j * 8 + c8) * 8); } \
        if (w == 0) { const int _p = dir ? 63 - lane : lane; g_i = GATES[(size_t)(_r0 + _p) * 16 + gi_col]; g_f = GATES[(size_t)(_r0 + _p) * 16 + gf_col]; } } while (0)
    ML_LOAD(0);
#pragma unroll 1
    for (int ci = 0; ci < 36; ++ci) {
        const bool lat = ci >= 4;
        const int row0 = ML_ROW0(ci);
#pragma unroll
        for (int j = 0; j < 4; ++j) *(LAS u32x4*)(lds + KS + sr * RQ + (j * 8 + c8) * 16) = rk[j];
        *(LAS u32x4*)(lds + VS + sr * RV + c8 * 16) = rv;
        if (lat) {
#pragma unroll
            for (int j = 0; j < 4; ++j) *(LAS u32x4*)(lds + QS + sr * RQ + (j * 8 + c8) * 16) = rq[j];
        }
        if (w == 0) {
            const float lf = fminf(g_f, 0.f) - __logf(1.f + __expf(-fabsf(g_f)));
            const float bc = wave_scan_add(lf);
            const float a = g_i - bc;
            const float pm = wave_scan_max(a);
            const float M = fmaxf(m_in, pm);
            const float M63 = __int_as_float(__builtin_amdgcn_readlane(__float_as_int(M), 63)), b63 = __int_as_float(__builtin_amdgcn_readlane(__float_as_int(bc), 63));
            const int p = dir ? 63 - lane : lane;
            *(LAS float*)(lds + SC_A + p * 4) = a;
            *(LAS float*)(lds + SC_M + p * 4) = M;
            *(LAS float*)(lds + SC_WI + p * 4) = __expf(m_in - M);
            *(LAS float*)(lds + SC_TH + p * 4) = __expf(-(bc + M));
            *(LAS float*)(lds + SC_WS + p * 4) = __expf(a - M63);
            if (lane == 0) *(LAS float*)(lds + SC_WC) = __expf(m_in - M63);
            m_in = b63 + M63;
        }
        __syncthreads();
        if (ci > 0 && tid < 256) *(LAS float*)(lds + NV + tid * 4) += *(LAS float*)(lds + NV2 + tid * 4);
        {
            const float wsv = *(LAS float*)(lds + SC_WS + sr * 4);
            u32x4 o;
            o.x = cvt_pk_bf16(bf_lo(rv.x) * wsv, bf_hi(rv.x) * wsv); o.y = cvt_pk_bf16(bf_lo(rv.y) * wsv, bf_hi(rv.y) * wsv);
            o.z = cvt_pk_bf16(bf_lo(rv.z) * wsv, bf_hi(rv.z) * wsv); o.w = cvt_pk_bf16(bf_lo(rv.w) * wsv, bf_hi(rv.w) * wsv);
            *(LAS u32x4*)(lds + VWS + sr * RV + c8 * 16) = o;
        }
        if (pend_b) { CV_FINISH(); pend_b = false; }
        if (ci + 1 < 36) ML_LOAD(ci + 1);
        CV_ISSUE();
        const int tb0 = 2 * (w >> 2);
        if (lat) {
            const int s0 = 16 * (w & 3);
            f32x4 accS[2] = {(f32x4){0.f, 0.f, 0.f, 0.f}, (f32x4){0.f, 0.f, 0.f, 0.f}};
#pragma unroll 2
            for (int ks = 0; ks < 8; ++ks) {
                const bf16x8 A = *(const LAS bf16x8*)(lds + KS + (s0 + i16) * RQ + (32 * ks + 8 * g) * 2);
#pragma unroll
                for (int tb = 0; tb < 2; ++tb) {
                    const bf16x8 B = *(const LAS bf16x8*)(lds + QS + (16 * (tb0 + tb) + i16) * RQ + (32 * ks + 8 * g) * 2);
                    accS[tb] = __builtin_amdgcn_mfma_f32_16x16x32_bf16(A, B, accS[tb], 0, 0, 0);
                }
            }
#pragma unroll
            for (int tb = 0; tb < 2; ++tb) {
                const int tp = 16 * (tb0 + tb) + i16;
                const float Mt = *(LAS float*)(lds + SC_M + tp * 4);
                float v[4];
#pragma unroll
                for (int r = 0; r < 4; ++r) {
                    const int sp = s0 + 4 * g + r;
                    const bool ok = dir ? (sp >= tp) : (sp <= tp);
                    const float as = *(LAS float*)(lds + SC_A + sp * 4);
                    v[r] = ok ? accS[tb][r] * __expf(as - Mt) : 0.f;
                }
                u32x2 o; o.x = cvt_pk_bf16(v[0], v[1]); o.y = cvt_pk_bf16(v[2], v[3]);
                *(LAS u32x2*)(lds + SS + tp * RV + (s0 + 4 * g) * 2) = o;
            }
        }
        __syncthreads();
        f32x4 accO[2] = {(f32x4){0.f, 0.f, 0.f, 0.f}, (f32x4){0.f, 0.f, 0.f, 0.f}};
        const int v0 = 16 * (w & 3);
        if (lat) {
            {
                const int t = sr, part = c8;
                const u32x4 sv = *(const LAS u32x4*)(lds + SS + t * RV + part * 16);
                float rs = bf_lo(sv.x) + bf_hi(sv.x) + bf_lo(sv.y) + bf_hi(sv.y) + bf_lo(sv.z) + bf_hi(sv.z) + bf_lo(sv.w) + bf_hi(sv.w);
                float qn = 0.f;
#pragma unroll
                for (int j = 0; j < 4; ++j) {
                    const u32x4 qv = *(const LAS u32x4*)(lds + QS + t * RQ + part * 64 + j * 16);
                    const f32x4 n0 = *(const LAS f32x4*)(lds + NV + (part * 32 + j * 8) * 4), n1 = *(const LAS f32x4*)(lds + NV + (part * 32 + j * 8 + 4) * 4);
                    qn += bf_lo(qv.x) * n0[0] + bf_hi(qv.x) * n0[1] + bf_lo(qv.y) * n0[2] + bf_hi(qv.y) * n0[3]
                        + bf_lo(qv.z) * n1[0] + bf_hi(qv.z) * n1[1] + bf_lo(qv.w) * n1[2] + bf_hi(qv.w) * n1[3];
                }
                rs = sum8_dpp(rs); qn = sum8_dpp(qn);
                if (part == 0) {
                    const float den = rs + *(LAS float*)(lds + SC_WI + t * 4) * qn;
                    *(LAS float*)(lds + SC_DEN + t * 4) = 1.f / fmaxf(fabsf(den), *(LAS float*)(lds + SC_TH + t * 4));
                }
            }
#pragma unroll 2
            for (int ks = 0; ks < 8; ++ks) {
                const bf16x8 A = *(const LAS bf16x8*)(lds + CTS + (v0 + i16) * RQ + (32 * ks + 8 * g) * 2);
#pragma unroll
                for (int tb = 0; tb < 2; ++tb) {
                    const bf16x8 B = *(const LAS bf16x8*)(lds + QS + (16 * (tb0 + tb) + i16) * RQ + (32 * ks + 8 * g) * 2);
                    accO[tb] = __builtin_amdgcn_mfma_f32_16x16x32_bf16(A, B, accO[tb], 0, 0, 0);
                }
            }
#pragma unroll
            for (int tb = 0; tb < 2; ++tb) accO[tb] *= *(LAS float*)(lds + SC_WI + (16 * (tb0 + tb) + i16) * 4);
#pragma unroll
            for (int s2 = 0; s2 < 2; ++s2) {
                const bf16x8 A = tr_pair(lds + VS + (32 * s2 + 8 * g + q4) * RV + (v0 + 4 * p4) * 2, 4 * RV);
#pragma unroll
                for (int tb = 0; tb < 2; ++tb) {
                    const bf16x8 B = *(const LAS bf16x8*)(lds + SS + (16 * (tb0 + tb) + i16) * RV + (32 * s2 + 8 * g) * 2);
                    accO[tb] = __builtin_amdgcn_mfma_f32_16x16x32_bf16(A, B, accO[tb], 0, 0, 0);
                }
            }
        }
        __syncthreads();
        if (lat) {
#pragma unroll
            for (int tb = 0; tb < 2; ++tb) {
                const int tp = 16 * (tb0 + tb) + i16;
                const float rd = *(LAS float*)(lds + SC_DEN + tp * 4);
                u32x2 o; o.x = cvt_pk_bf16(accO[tb][0] * rd, accO[tb][1] * rd); o.y = cvt_pk_bf16(accO[tb][2] * rd, accO[tb][3] * rd);
                *(u32x2*)(Hout + (size_t)(row0 + tp) * 2048 + h * 512 + vs * 64 + v0 + 4 * g) = o;
            }
        }
        CV_FINISH();
        if ((ci % 3) == 0) { CV_ISSUE(); pend_b = true; }
        {
            const float wcv = *(LAS float*)(lds + SC_WC);
            const int k0 = 32 * w;
#pragma unroll
            for (int a = 0; a < 2; ++a)
#pragma unroll
                for (int v = 0; v < 4; ++v) accC[a][v] *= wcv;
#pragma unroll
            for (int s2 = 0; s2 < 2; ++s2) {
                bf16x8 A[2], B[4];
#pragma unroll
                for (int a = 0; a < 2; ++a) A[a] = tr_pair(lds + KS + (32 * s2 + 8 * g + q4) * RQ + (k0 + 16 * a + 4 * p4) * 2, 4 * RQ);
#pragma unroll
                for (int v = 0; v < 4; ++v) B[v] = tr_pair(lds + VWS + (32 * s2 + 8 * g + q4) * RV + (16 * v + 4 * p4) * 2, 4 * RV);
#pragma unroll
                for (int a = 0; a < 2; ++a)
#pragma unroll
                    for (int v = 0; v < 4; ++v) accC[a][v] = __builtin_amdgcn_mfma_f32_16x16x32_bf16(A[a], B[v], accC[a][v], 0, 0, 0);
            }
#pragma unroll
            for (int a = 0; a < 2; ++a)
#pragma unroll
                for (int v = 0; v < 4; ++v) {
                    u32x2 o; o.x = cvt_pk_bf16(accC[a][v][0], accC[a][v][1]); o.y = cvt_pk_bf16(accC[a][v][2], accC[a][v][3]);
                    *(LAS u32x2*)(lds + CTS + (16 * v + i16) * RQ + (k0 + 16 * a + 4 * g) * 2) = o;
                }
            {
                const int kk_ = tid & 255, hf_ = tid >> 8;
                float nv = hf_ ? 0.f : wcv * *(LAS float*)(lds + NV + kk_ * 4);
#pragma unroll 8
                for (int s = 0; s < 32; ++s) nv += *(LAS float*)(lds + SC_WS + (hf_ * 32 + s) * 4) * bf_s(*(const LAS unsigned short*)(lds + KS + (hf_ * 32 + s) * RQ + kk_ * 2));
                *(LAS float*)(lds + (hf_ ? NV2 : NV) + kk_ * 4) = nv;
            }
        }
        __syncthreads();
    }
    if (pend_b) CV_FINISH();
#undef ML_ROW0
#undef ML_LOAD
}
}

__global__ void __launch_bounds__(NTHREADS, 2) fwd(Args args) {
    extern __shared__ __attribute__((aligned(16))) unsigned char lds_raw[];
    LAS unsigned char* lds = (LAS unsigned char*)lds_raw;
    volatile LAS unsigned* MISC = (volatile LAS unsigned*)(lds + MISC_OFF);
    const int wave = __builtin_amdgcn_readfirstlane((int)threadIdx.x >> 6);
    const int G = gridDim.x, bx = blockIdx.x;
    const int vcu = (G % 8 == 0) ? (bx % 8) * (G / 8) + bx / 8 : bx;
    unsigned char* ws = args.ws;
    unsigned* ctl = (unsigned*)(ws + WS_CTL);
    { const int tid0 = wave * 64 + lane_id_(); for (int u = tid0; u < 256; u += NTHREADS) MISC[u] = 0u; }
    __syncthreads();
    XcdBarrier bar = xcd_barrier_post(ctl + CW_BAR, MISC, wave == 0 && lane_id_() == 0);
    const int lo = args.ph_lo, hi = args.ph_hi;
#define IN(k) (lo <= (k) && (k) < hi)
#define NREP(k) (1 + ((REP_MASK >> (k)) & 1))
#define SEAM(k) do { if (IN(k) && IN((k) + 1)) xcd_barrier(bar, wave); } while (0)

    const float* x = args.in[0]; const float* cvec = args.in[1]; const float* ctx = args.in[2]; const float* c_ctx = args.in[3];
    const float* w_mod = args.in[4]; const float* b_mod = args.in[5]; const float* g_norm1 = args.in[6]; const float* g_norm2 = args.in[7];
    const float* w_in = args.in[8]; const float* b_in = args.in[9]; const float* g_q = args.in[10]; const float* g_k = args.in[11]; const float* g_mh = args.in[12];
    const float* w_br_m = args.in[13]; const float* w_br_a = args.in[14]; const float* w_out = args.in[15];
    const float* w_router = args.in[16]; const float* b_router = args.in[17]; const float* w_gu = args.in[18]; const float* b_gu = args.in[19];
    const float* w_dn = args.in[20]; const float* b_dn = args.in[21];
    float* out = args.out;
    float* MOD = (float*)(ws + WS_MOD); float* BINP = (float*)(ws + WS_BINP);
    bf16_t* WTIN = (bf16_t*)(ws + WS_WTIN); bf16_t* WTBRM = (bf16_t*)(ws + WS_WTBRM); bf16_t* WTBRA = (bf16_t*)(ws + WS_WTBRA); bf16_t* WTOUT = (bf16_t*)(ws + WS_WTOUT);
    unsigned char* WTGU = ws + WS_WTGU; unsigned char* WTDN = ws + WS_WTDN;
    bf16_t* U = (bf16_t*)(ws + WS_U); bf16_t* PM = (bf16_t*)(ws + WS_PM); float* GATES = (float*)(ws + WS_GATES);
    unsigned char* OG8 = ws + WS_AQ;        bf16_t* AK = (bf16_t*)(ws + WS_AK); bf16_t* VV = (bf16_t*)(ws + WS_VV); bf16_t* KR = (bf16_t*)(ws + WS_KR); bf16_t* QR = (bf16_t*)(ws + WS_QR);
    unsigned char* MG = ws + WS_MG; bf16_t* AO = (bf16_t*)(ws + WS_AO); bf16_t* HF = (bf16_t*)(ws + WS_HF); bf16_t* HB = (bf16_t*)(ws + WS_HB);
    bf16_t* MX = (bf16_t*)(ws + WS_MX); bf16_t* MRG = (bf16_t*)(ws + WS_MRG); unsigned char* U2 = ws + WS_U2;
    int* TOPE = (int*)(ws + WS_TOPE); int* TOPP = (int*)(ws + WS_TOPP); float* TOPW = (float*)(ws + WS_TOPW); int* LIST = (int*)(ws + WS_LIST);
    unsigned char* HID = ws + WS_HID; bf16_t* Y = (bf16_t*)(ws + WS_Y); unsigned char* WTIN8 = ws + WS_WTIN8; unsigned char* U8 = ws + WS_U8;
    unsigned char* W8BRM = ws + WS_W8BRM; unsigned char* W8BRA = ws + WS_W8BRA; unsigned char* W8OUT = ws + WS_W8OUT; unsigned char* MX8 = ws + WS_MX8; unsigned char* AO8 = ws + WS_AO8; unsigned char* MRG8 = ws + WS_MRG8; float* ROPE = (float*)(ws + WS_ROPE); bf16_t* HX1 = (bf16_t*)(ws + WS_HX1);
    unsigned* ECNT = ctl + CW_CNT;

    if (IN(0)) {
        const int lane = lane_id_(), tid = wave * 64 + lane; (void)tid; (void)lane;
_Pragma("unroll")
    for (int rep_ = 0; rep_ < NREP(0); ++rep_) { if (rep_) xcd_barrier(bar, wave);
        if (bx < 192) {
            LAS float* sc = (LAS float*)lds;
            LAS float* red = (LAS float*)(lds + 5 * 2048 * 4);
            for (int idx = tid; idx < 5 * 2048; idx += NTHREADS) { const int r = idx >> 11, k = idx & 2047; const float v = (r < 4) ? cvec[r * 2048 + k] : c_ctx[k]; sc[idx] = v / (1.f + __expf(-v)); }
            __syncthreads();
            const int cq = lane & 15, kr = lane >> 4;
            f32x4 ac[5];
#pragma unroll
            for (int r = 0; r < 5; ++r) ac[r] = (f32x4){0.f, 0.f, 0.f, 0.f};
            const float* wp = w_mod + (size_t)(wave * 256 + kr) * 12288 + bx * 64 + cq * 4;
#pragma unroll 8
            for (int kk = 0; kk < 64; ++kk) {
                const f32x4 wv = *(const f32x4*)(wp + (size_t)kk * 4 * 12288); const int k = wave * 256 + kk * 4 + kr;
#pragma unroll
                for (int r = 0; r < 5; ++r) ac[r] += wv * sc[r * 2048 + k];
            }
#pragma unroll
            for (int r = 0; r < 5; ++r) {
#pragma unroll
                for (int j = 0; j < 4; ++j) {
                    float v = ac[r][j];
                    { auto r_ = __builtin_amdgcn_permlane16_swap(__float_as_uint(v), __float_as_uint(v), false, false); v = __uint_as_float(r_[0]) + __uint_as_float(r_[1]); }
                    { auto r_ = __builtin_amdgcn_permlane32_swap(__float_as_uint(v), __float_as_uint(v), false, false); v = __uint_as_float(r_[0]) + __uint_as_float(r_[1]); }
                    ac[r][j] = v;
                }
                if (kr == 0) *(LAS f32x4*)(red + (wave * 5 + r) * 64 + cq * 4) = ac[r];
            }
            __syncthreads();
            if (tid < 320) { const int r = tid >> 6, l = tid & 63; float s = 0.f;
#pragma unroll
                for (int ww = 0; ww < 8; ++ww) s += red[(ww * 5 + r) * 64 + l];
                MOD[r * 12288 + bx * 64 + l] = s + b_mod[bx * 64 + l]; }
            __syncthreads();
        }
        const int gtid = bx * NTHREADS + tid, gthreads = G * NTHREADS;
        for (int n = gtid; n < NP; n += gthreads) {
            float v = 0.f;
            if (n < 6144) v = b_in[n]; else if (n < 13312) v = b_in[n + 16]; else if (n < 13328) v = b_in[6144 + (n - 13312)];
            BINP[n] = v;
        }
        for (int idx = gtid; idx < (NP - F_IN) * (D / 8); idx += gthreads) *(u32x4*)(WTIN + (size_t)F_IN * D + (size_t)idx * 8) = (u32x4){0u, 0u, 0u, 0u};
        {
            const int nq = lane & 7, ks = lane >> 3;
            constexpr int T_IN = 16 * 417, T_SQ = 16 * 64;
            constexpr int T_ALL = T_IN + 3 * T_SQ;
            const bool wt = (G == 256);
            const int nw = wt ? 2560 : G * 8, nstream = (wt && bx >= 192) ? 2 : 1;
#pragma unroll 1
            for (int vs_ = 0; vs_ < nstream; ++vs_) {
            const int gw = !wt ? bx * 8 + wave : (bx < 192 ? bx * 8 + wave : 1536 + ((bx - 192) * 8 + wave) * 2 + vs_);
#pragma unroll 1
            for (int t = gw; t < T_ALL; t += nw) {
                const float* src; int N, nb, kb, mode; unsigned char* dstb; bool f8;
                if (t < T_IN) { nb = t % 417; kb = t / 417; src = w_in; N = F_IN; dstb = (unsigned char*)WTIN; mode = 1; f8 = false; }
                else { const int q = t - T_IN, mtx = q / T_SQ, r = q % T_SQ; nb = r & 63; kb = r >> 6; N = 2048; mode = 0; f8 = true;
                    src = mtx == 0 ? w_br_m : (mtx == 1 ? w_br_a : w_out); dstb = mtx == 0 ? W8BRM : (mtx == 1 ? W8BRA : W8OUT); }
                const int n = nb * 32 + nq * 4;
                if (n < N) {
                    const float* sp = src + (size_t)(kb * 128 + ks * 16) * N + n;
                    f32x4 v[16];
#pragma unroll
                    for (int kk = 0; kk < 16; ++kk) v[kk] = *(const f32x4*)(sp + (size_t)kk * N);
                    int nd = n;
                    if (mode == 1) nd = n < 6144 ? n : (n < 6160 ? 13312 + (n - 6144) : n - 16);
                    if (mode == 2) { const int j = n & 2047; nd = (j >> 7) * 256 + ((n >> 11) << 7) + (j & 127); }
                    bool f8l = f8;
                    if (mode == 1 && nd >= 2048 && nd < 13312) { f8l = true; nd -= 2048; dstb = WTIN8; }
                    if (f8l) {
                        unsigned char* dp = dstb + (size_t)nd * D + kb * 128 + ks * 16;
#pragma unroll
                        for (int j = 0; j < 4; ++j) {
                            u32x4 w;
                            w.x = pk4_fp8(v[0][j] * WSCALE, v[1][j] * WSCALE, v[2][j] * WSCALE, v[3][j] * WSCALE);
                            w.y = pk4_fp8(v[4][j] * WSCALE, v[5][j] * WSCALE, v[6][j] * WSCALE, v[7][j] * WSCALE);
                            w.z = pk4_fp8(v[8][j] * WSCALE, v[9][j] * WSCALE, v[10][j] * WSCALE, v[11][j] * WSCALE);
                            w.w = pk4_fp8(v[12][j] * WSCALE, v[13][j] * WSCALE, v[14][j] * WSCALE, v[15][j] * WSCALE);
                            *(u32x4*)(dp + (size_t)j * D) = w;
                        }
                    } else {
                        unsigned char* dp = dstb + ((size_t)nd * D + kb * 128 + ks * 16) * 2;
#pragma unroll
                        for (int j = 0; j < 4; ++j) {
                            u32x4 w0, w1;
                            w0.x = cvt_pk_bf16(v[0][j], v[1][j]); w0.y = cvt_pk_bf16(v[2][j], v[3][j]); w0.z = cvt_pk_bf16(v[4][j], v[5][j]); w0.w = cvt_pk_bf16(v[6][j], v[7][j]);
                            w1.x = cvt_pk_bf16(v[8][j], v[9][j]); w1.y = cvt_pk_bf16(v[10][j], v[11][j]); w1.z = cvt_pk_bf16(v[12][j], v[13][j]); w1.w = cvt_pk_bf16(v[14][j], v[15][j]);
                            *(u32x4*)(dp + (size_t)j * D * 2) = w0; *(u32x4*)(dp + (size_t)j * D * 2 + 16) = w1;
                        }
                    }
                }
            }
            }
        }
    } }
    SEAM(0);

    if (IN(1)) {
        const int lane = lane_id_(), tid = wave * 64 + lane; (void)tid; (void)lane;
_Pragma("unroll")
    for (int rep_ = 0; rep_ < NREP(1); ++rep_) { if (rep_) xcd_barrier(bar, wave);
        if (bx == G - 1) {
            for (int i = tid; i < 2048; i += 512) {
                float sn_, cs_; sincosf((float)(i >> 5) * __expf(-9.210340371976184f * (float)(i & 31) * (1.f / 32.f)), &sn_, &cs_);
                ROPE[i] = cs_; ROPE[2048 + i] = sn_;
            }
        }
        for (int row = bx * 8 + wave; row < NROW; row += G * 8) {
            const float* src = row < NLAT ? x + (size_t)row * D : ctx + (size_t)(row - NLAT) * D;
            const float* md = MOD + (size_t)(row < NLAT ? (row >> 11) : 4) * 12288;
            f32x4 v[8]; float ss = 0.f;
#pragma unroll
            for (int i = 0; i < 8; ++i) { v[i] = *(const f32x4*)(src + lane * 4 + 256 * i); ss += v[i][0] * v[i][0] + v[i][1] * v[i][1] + v[i][2] * v[i][2] + v[i][3] * v[i][3]; }
            ss = wave_sum(ss);
            const float rstd = rsqrtf(ss * (1.f / D) + EPS);
#pragma unroll
            for (int i = 0; i < 8; ++i) {
                const int c = lane * 4 + 256 * i;
                const f32x4 gg = *(const f32x4*)(g_norm1 + c), sh = *(const f32x4*)(md + c), sc = *(const f32x4*)(md + 2048 + c);
                const f32x4 y = v[i] * rstd * gg; const f32x4 uu = y * (sc + 1.f) + sh;
                u32x2 o; o.x = cvt_pk_bf16(uu[0], uu[1]); o.y = cvt_pk_bf16(uu[2], uu[3]);
                *(u32x2*)(U + (size_t)row * D + c) = o;
                *(unsigned*)(U8 + (size_t)row * D + c) = pk4_fp8(uu[0], uu[1], uu[2], uu[3]);
            }
        }
    } }
    SEAM(1);

    if (IN(2)) {
        const int lane = lane_id_(), tid = wave * 64 + lane; (void)tid; (void)lane;
_Pragma("unroll")
    for (int rep_ = 0; rep_ < NREP(2); ++rep_) { if (rep_) xcd_barrier(bar, wave);
        {
            SchedInprojA S{G, bx};
            g8::OpsPlain O{U, WTIN, D};
            EpiInprojT<false> E{PM, QR, KR, VV, MG, OG8, GATES, BINP, 1.f, g_q, g_k, ROPE, lds};
            g8::gemm_phase<EpiInprojT<false>, SchedInprojA, g8::OpsPlain>(lds, D * 2, S, O, E, wave);
        }
        {
            SchedInprojB S{G, (G == 256) ? ((bx + 256 - 56) & 255) : bx};
            OpsPlain8 O{U8, WTIN8, 8};
            EpiInprojT<true> E{PM, QR, KR, VV, MG, OG8, GATES, BINP, WINV, g_q, g_k, ROPE, lds};
            g8::gemm_phase<EpiInprojT<true>, SchedInprojB, OpsPlain8, true>(lds, D, S, O, E, wave);
        }
    } }
    SEAM(2);


    using ml::T_GU; using ml::T_CONV;
    if (IN(4)) {
        const int lane = lane_id_(), tid = wave * 64 + lane; (void)tid; (void)lane;
        const bool att_first = (vcu & 1) != 0;
#define ATT_BLOCK() do { _Pragma("unroll 1") for (int rep_ = 0; rep_ < NREP(12); ++rep_) { \
            for (int L = vcu; L < 512; L += G) { \
                const int pair = L >> 5, r = L & 31, b = pair >> 2, kvh = pair & 3, hq = kvh * 4 + (r >> 3), qb = r & 7; \
                const size_t qoff = ((size_t)(b * TSEQ + qb * 256)) * 2048 + hq * 128; \
                const size_t koff = ((size_t)b * KVLEN) * 512 + kvh * 128; \
                att::attn_dense_body(QR + qoff, KR + koff, VV + koff, AO8 + qoff, KVLEN, (char*)lds_raw, lds, wave); \
            } } } while (0)
        if (att_first) { ATT_BLOCK(); __syncthreads(); }
#pragma unroll 1
        for (int rep_ = 0; rep_ < NREP(4); ++rep_) {
            ml::Conv cvs{w_gu, w_dn, WTGU, WTDN, bx * 8 + wave, G * 8};
            for (int un = vcu; un < 256; un += G) {
                const int bh = un >> 4, dir = (un >> 3) & 1, vs = un & 7;
                ml::mlstm_unit(lds, PM, GATES, dir ? HB : HF, bh >> 2, bh & 3, dir, vs, cvs, wave);
            }
            {
                f32x4 cv[16];
#pragma unroll 1
                while (cvs.t < ml::T_CONV) { CV_ISSUE(); CV_FINISH(); }
            }
        }
        __syncthreads();
        if (!att_first) { ATT_BLOCK(); }
#undef ATT_BLOCK
    }
    SEAM(4);

    if (IN(5)) {
        const int lane = lane_id_(), tid = wave * 64 + lane; (void)tid; (void)lane;
_Pragma("unroll")
    for (int rep_ = 0; rep_ < NREP(5); ++rep_) { if (rep_) xcd_barrier(bar, wave);
        for (int it = bx * 8 + wave; it < NLAT * 4; it += G * 8) {
            const int tok = it >> 2, hh = it & 3;
            const size_t off = (size_t)tok * 2048 + hh * 512 + lane * 8;
            const u32x4 a = *(const u32x4*)(HF + off), bq = *(const u32x4*)(HB + off);
            float hs[8];
            hs[0] = bf_lo(a.x) + bf_lo(bq.x); hs[1] = bf_hi(a.x) + bf_hi(bq.x); hs[2] = bf_lo(a.y) + bf_lo(bq.y); hs[3] = bf_hi(a.y) + bf_hi(bq.y);
            hs[4] = bf_lo(a.z) + bf_lo(bq.z); hs[5] = bf_hi(a.z) + bf_hi(bq.z); hs[6] = bf_lo(a.w) + bf_lo(bq.w); hs[7] = bf_hi(a.w) + bf_hi(bq.w);
            float ss = 0.f;
#pragma unroll
            for (int j = 0; j < 8; ++j) ss += hs[j] * hs[j];
            ss = wave_sum(ss);
            const float rstd = rsqrtf(ss * (1.f / 512.f) + EPS);
            const u32x2 ov = *(const u32x2*)(OG8 + (size_t)tok * 2048 + hh * 512 + lane * 8);
            const f32x4 g0 = *(const f32x4*)(g_mh + hh * 512 + lane * 8), g1 = *(const f32x4*)(g_mh + hh * 512 + lane * 8 + 4);
            float op[8] = {(float)(ov.x & 0xffu), (float)((ov.x >> 8) & 0xffu), (float)((ov.x >> 16) & 0xffu), (float)(ov.x >> 24), (float)(ov.y & 0xffu), (float)((ov.y >> 8) & 0xffu), (float)((ov.y >> 16) & 0xffu), (float)(ov.y >> 24)};
            float r[8];
#pragma unroll
            for (int j = 0; j < 8; ++j) r[j] = hs[j] * (rstd * (1.f / 255.f)) * (j < 4 ? g0[j] : g1[j - 4]) * op[j];
            u32x2 o; o.x = pk4_fp8(r[0], r[1], r[2], r[3]); o.y = pk4_fp8(r[4], r[5], r[6], r[7]);
            *(u32x2*)(MX8 + off) = o;
        }
    } }
    SEAM(5);

    if (IN(6)) {
        const int lane = lane_id_(), tid = wave * 64 + lane; (void)tid; (void)lane;
_Pragma("unroll")
    for (int rep_ = 0; rep_ < NREP(6); ++rep_) { if (rep_) xcd_barrier(bar, wave);
        SchedDual S{G, bx};
        OpsDual O{MX8, AO8, W8BRM, W8BRA};
        EpiMerge E{MG, MRG8};
        g8::gemm_phase<EpiMerge, SchedDual, OpsDual, true>(lds, D, S, O, E, wave);
    } }
    SEAM(6);

    if (IN(7)) {
        const int lane = lane_id_(), tid = wave * 64 + lane; (void)tid; (void)lane;
_Pragma("unroll")
    for (int rep_ = 0; rep_ < NREP(7); ++rep_) { if (rep_) xcd_barrier(bar, wave);
        SchedSquare S{G, bx, 32, 8};
        OpsPlain8 O{MRG8, W8OUT, 0};
        EpiOut E{x, MOD, HX1, 1.f / (WSCALE * MRG_SCALE)};
        g8::gemm_phase<EpiOut, SchedSquare, OpsPlain8, true>(lds, D, S, O, E, wave);
    } }
    SEAM(7);

    if (IN(8)) {
        const int lane = lane_id_(), tid = wave * 64 + lane; (void)tid; (void)lane;
        LAS float* ut = (LAS float*)lds;
        LAS float* part = (LAS float*)(lds + 65536);
        LAS float* lg = (LAS float*)(lds + 65536 + 16384);
        LAS int* asg_tok = (LAS int*)(lds + 65536 + 16384 + 1024);
        LAS int* asg_e = asg_tok + 256; LAS float* asg_w = (LAS float*)(asg_e + 256);
        LAS int* hist = asg_e + 512; LAS int* hbase = hist + 32;
        int nit = 0;
#define P8_FLUSH() do {     \
            const int nas = nit * 32; \
            if (tid < 32) hist[tid] = 0; \
            __syncthreads(); \
            int my_e = 0, my_rank = 0; \
            if (tid < nas) { my_e = asg_e[tid]; my_rank = atomicAdd((int*)&hist[my_e], 1); } \
            __syncthreads(); \
            if (tid < 32) { const int c_ = hist[tid]; hbase[tid] = c_ ? (int)atomicAdd(&ECNT[tid], (unsigned)c_) : 0; } \
            __syncthreads(); \
            if (tid < nas) { \
                const int pos_ = hbase[my_e] + my_rank, tok_ = asg_tok[tid]; \
                LIST[my_e * NLAT + pos_] = tok_; \
                TOPE[tok_ * 4 + (tid & 3)] = my_e; TOPP[tok_ * 4 + (tid & 3)] = pos_; TOPW[tok_ * 4 + (tid & 3)] = asg_w[tid]; \
            } \
            __syncthreads(); nit = 0; } while (0)
        const int e = lane & 31, jh = lane >> 5, jb = wave * 256 + jh * 128;
        float wv[128];
        {
            const float* wrp = w_router + (size_t)jb * 32 + e;
#pragma unroll
            for (int q = 0; q < 128; ++q) wv[q] = wrp[q * 32];
        }
        u32x4 hv[4];
#define P8_LOADV(T0) do { const bf16_t* src_ = HX1 + (size_t)((T0) + wave) * D; _Pragma("unroll") for (int i = 0; i < 4; ++i) hv[i] = *(const u32x4*)(src_ + lane * 8 + 512 * i); } while (0)
        LAS float* gsv = (LAS float*)(lds + 96 * 1024); LAS float* shv = (LAS float*)(lds + 104 * 1024);
        const int nblk = NLAT / 8, per_ = (nblk + G - 1) / G, blk0 = bx * per_, blk1 = (blk0 + per_ < nblk) ? blk0 + per_ : nblk;
        int cur_b = -1;
        if (blk0 < blk1) P8_LOADV(blk0 * 8);
        for (int blk = blk0; blk < blk1; ++blk) {
            const int t0 = blk * 8;
            if ((t0 >> 11) != cur_b) {
                cur_b = t0 >> 11;
                const float* md = MOD + (size_t)cur_b * 12288; const int c = tid * 4;
                const f32x4 gg = *(const f32x4*)(g_norm2 + c), sh = *(const f32x4*)(md + 6144 + c), sc = *(const f32x4*)(md + 8192 + c);
                *(LAS f32x4*)(gsv + c) = gg * (sc + 1.f); *(LAS f32x4*)(shv + c) = sh;
                __syncthreads();
            }
            {
                const int tok = t0 + wave;
                f32x4 v[8]; float ss = 0.f;
#pragma unroll
                for (int i = 0; i < 4; ++i) {
                    v[2 * i] = (f32x4){bf_lo(hv[i].x), bf_hi(hv[i].x), bf_lo(hv[i].y), bf_hi(hv[i].y)}; v[2 * i + 1] = (f32x4){bf_lo(hv[i].z), bf_hi(hv[i].z), bf_lo(hv[i].w), bf_hi(hv[i].w)};
                }
#pragma unroll
                for (int i = 0; i < 8; ++i) ss += v[i][0] * v[i][0] + v[i][1] * v[i][1] + v[i][2] * v[i][2] + v[i][3] * v[i][3];
                ss = wave_sum(ss);
                const float rstd = rsqrtf(ss * (1.f / D) + EPS);
#pragma unroll
                for (int i = 0; i < 4; ++i) {
                    const int c = lane * 8 + 512 * i;
                    const f32x4 u0 = v[2 * i] * rstd * *(const LAS f32x4*)(gsv + c) + *(const LAS f32x4*)(shv + c);
                    const f32x4 u1 = v[2 * i + 1] * rstd * *(const LAS f32x4*)(gsv + c + 4) + *(const LAS f32x4*)(shv + c + 4);
                    *(LAS f32x4*)(ut + wave * 2048 + c) = u0; *(LAS f32x4*)(ut + wave * 2048 + c + 4) = u1;
                    u32x2 w8; w8.x = pk4_fp8(u0[0], u0[1], u0[2], u0[3]); w8.y = pk4_fp8(u1[0], u1[1], u1[2], u1[3]);
                    *(u32x2*)(U2 + (size_t)tok * D + c) = w8;
                }
            }
            if (blk + 1 < blk1) P8_LOADV(t0 + 8);
            __syncthreads();
            {
                float a[8] = {0.f, 0.f, 0.f, 0.f, 0.f, 0.f, 0.f, 0.f};
#pragma unroll
                for (int th = 0; th < 8; th += 4) {
                    f32x4 ua[4], ub[4];
#pragma unroll
                    for (int tk = 0; tk < 4; ++tk) ua[tk] = *(const LAS f32x4*)(ut + (th + tk) * 2048 + jb);
#pragma unroll
                    for (int jj = 0; jj < 128; jj += 8) {
#pragma unroll
                        for (int tk = 0; tk < 4; ++tk) ub[tk] = *(const LAS f32x4*)(ut + (th + tk) * 2048 + jb + jj + 4);
#pragma unroll
                        for (int tk = 0; tk < 4; ++tk) a[th + tk] += ua[tk][0] * wv[jj] + ua[tk][1] * wv[jj + 1] + ua[tk][2] * wv[jj + 2] + ua[tk][3] * wv[jj + 3];
                        if (jj + 8 < 128) {
#pragma unroll
                            for (int tk = 0; tk < 4; ++tk) ua[tk] = *(const LAS f32x4*)(ut + (th + tk) * 2048 + jb + jj + 8);
                        }
#pragma unroll
                        for (int tk = 0; tk < 4; ++tk) a[th + tk] += ub[tk][0] * wv[jj + 4] + ub[tk][1] * wv[jj + 5] + ub[tk][2] * wv[jj + 6] + ub[tk][3] * wv[jj + 7];
                    }
                }
#pragma unroll
                for (int tk = 0; tk < 8; ++tk) part[((wave * 2 + jh) * 8 + tk) * 32 + e] = a[tk];
            }
            __syncthreads();
            {
                const int tok = t0 + wave;
                float v = -INFINITY;
                if (lane < 32) { float s = b_router[lane];
#pragma unroll
                    for (int p = 0; p < 16; ++p) s += part[(p * 8 + wave) * 32 + lane];
                    v = s; }
                float tl[4]; int te[4];
#pragma unroll
                for (int k = 0; k < 4; ++k) {
                    const float mx = wave_max(v);
                    const unsigned long long bm = __ballot(v == mx);
                    const int e = __ffsll((long long)bm) - 1;
                    tl[k] = mx; te[k] = e;
                    if (lane == e) v = -INFINITY;
                }
                const float e1 = __expf(tl[1] - tl[0]), e2 = __expf(tl[2] - tl[0]), e3 = __expf(tl[3] - tl[0]);
                const float inv = 1.f / (1.f + e1 + e2 + e3);
                if (lane < 4) {
                    const int e = lane == 0 ? te[0] : (lane == 1 ? te[1] : (lane == 2 ? te[2] : te[3]));
                    const float wgt = (lane == 0 ? 1.f : (lane == 1 ? e1 : (lane == 2 ? e2 : e3))) * inv;
                    const int slot = (nit * 8 + wave) * 4 + lane;
                    asg_tok[slot] = tok; asg_e[slot] = e; asg_w[slot] = wgt;
                }
            }
            ++nit;
            __syncthreads();
            if (nit == 8) P8_FLUSH();
        }
        if (nit > 0) P8_FLUSH();
#undef P8_FLUSH
#undef P8_LOADV
    }
    SEAM(8);

    volatile LAS int* mstart = (volatile LAS int*)(MISC + 16);
    volatile LAS int* ecnt_l = (volatile LAS int*)(MISC + 52);
    volatile LAS int* texp_l = (volatile LAS int*)(MISC + 88);
    if (IN(9) || IN(10) || IN(11)) {
        const int lane = lane_id_();
        if (wave == 0) {
            const int c = lane < 32 ? (int)__hip_atomic_load(&ECNT[lane & 31], __ATOMIC_RELAXED, __HIP_MEMORY_SCOPE_AGENT) : 0;
            int n = (c + 255) >> 8;
#pragma unroll
            for (int o = 1; o < 64; o <<= 1) { const int t = __shfl_up(n, o, 64); if (lane >= o) n += t; }
            if (lane < 32) { mstart[lane + 1] = n; ecnt_l[lane] = c; }
            if (lane == 0) mstart[0] = 0;
        }
        __syncthreads();
        {
            const int tid2 = wave * 64 + lane;
            if (tid2 < 32) { const int a = mstart[tid2], b = mstart[tid2 + 1]; for (int t = a; t < b; ++t) texp_l[t] = tid2; }
        }
        __syncthreads();
    }
    if (IN(9)) {
        const int lane = lane_id_(), tid = wave * 64 + lane; (void)tid; (void)lane;
_Pragma("unroll")
    for (int rep_ = 0; rep_ < NREP(9); ++rep_) { if (rep_) xcd_barrier(bar, wave);
        SchedMoe S{G, vcu, 16, mstart, texp_l, ecnt_l, 0};
        OpsMoe1 O{U2, WTGU, LIST, ecnt_l};
        EpiMoe1 E{HID, b_gu};
        g8::gemm_phase<EpiMoe1, SchedMoe, OpsMoe1, true>(lds, D, S, O, E, wave);
    } }
    SEAM(9);
    if (IN(10)) {
        const int lane = lane_id_(), tid = wave * 64 + lane; (void)tid; (void)lane;
_Pragma("unroll")
    for (int rep_ = 0; rep_ < NREP(10); ++rep_) { if (rep_) xcd_barrier(bar, wave);
        SchedMoe S{G, vcu, 8, mstart, texp_l, ecnt_l, 1};
        OpsMoe2 O{HID, WTDN};
        EpiMoe2 E{Y, b_dn};
        g8::gemm_phase<EpiMoe2, SchedMoe, OpsMoe2, true>(lds, D, S, O, E, wave);
    } }
    SEAM(10);

    if (IN(11)) {
        const int lane = lane_id_(), tid = wave * 64 + lane; (void)tid; (void)lane;
        for (int tok = bx * 8 + wave; tok < NLAT; tok += G * 8) {
            const float* md = MOD + (size_t)(tok >> 11) * 12288 + 10240;
            size_t ro[4]; float wk[4];
#pragma unroll
            for (int k = 0; k < 4; ++k) { const int e = TOPE[tok * 4 + k]; ro[k] = ((size_t)mstart[e] * 256 + TOPP[tok * 4 + k]) * 2048; wk[k] = TOPW[tok * 4 + k]; }
#pragma unroll
            for (int i = 0; i < 4; ++i) {
                const int c = lane * 8 + 512 * i;
                float s[8] = {0.f, 0.f, 0.f, 0.f, 0.f, 0.f, 0.f, 0.f};
#pragma unroll
                for (int k = 0; k < 4; ++k) {
                    const u32x4 yv = *(const u32x4*)(Y + ro[k] + c);
                    s[0] += wk[k] * bf_lo(yv.x); s[1] += wk[k] * bf_hi(yv.x); s[2] += wk[k] * bf_lo(yv.y); s[3] += wk[k] * bf_hi(yv.y);
                    s[4] += wk[k] * bf_lo(yv.z); s[5] += wk[k] * bf_hi(yv.z); s[6] += wk[k] * bf_lo(yv.w); s[7] += wk[k] * bf_hi(yv.w);
                }
                float* op = out + (size_t)tok * D + c;
                const u32x4 hq = *(const u32x4*)(HX1 + (size_t)tok * D + c);
                const f32x4 h0 = (f32x4){bf_lo(hq.x), bf_hi(hq.x), bf_lo(hq.y), bf_hi(hq.y)}, h1 = (f32x4){bf_lo(hq.z), bf_hi(hq.z), bf_lo(hq.w), bf_hi(hq.w)};
                const f32x4 g0 = *(const f32x4*)(md + c), g1 = *(const f32x4*)(md + c + 4);
                f32x4 r0, r1;
#pragma unroll
                for (int j = 0; j < 4; ++j) { r0[j] = h0[j] + g0[j] * s[j]; r1[j] = h1[j] + g1[j] * s[4 + j]; }
                *(f32x4*)op = r0; *(f32x4*)(op + 4) = r1;
            }
        }
    }
#undef IN
#undef SEAM
}

#ifndef MK_SPLIT
#define MK_SPLIT 0
#endif
constexpr int NPHASE = 12;
extern "C" void kernel_launch(void* const* d_in, const int* in_sizes, int n_in, void* d_out, int out_size, void* d_ws, size_t ws_size, hipStream_t stream) {
    static int grid = 0;
    if (grid == 0) {
        if (n_in != 22 || out_size != NLAT * D || ws_size < WS_END) { fprintf(stderr, "kernel_launch: unexpected shapes (n_in %d out %d ws %zu need %zu)\n", n_in, out_size, ws_size, (size_t)WS_END); grid = -1; return; }
        int dev = 0, cus = 0, per_cu = 0;
        if (hipGetDevice(&dev) != hipSuccess || hipDeviceGetAttribute(&cus, hipDeviceAttributeMultiprocessorCount, dev) != hipSuccess) { grid = -1; return; }
        if (hipFuncSetAttribute((const void*)fwd, hipFuncAttributeMaxDynamicSharedMemorySize, LDS_TOTAL) != hipSuccess) { fprintf(stderr, "kernel_launch: hipFuncSetAttribute failed\n"); grid = -1; return; }
        if (hipOccupancyMaxActiveBlocksPerMultiprocessor(&per_cu, (const void*)fwd, NTHREADS, LDS_TOTAL) != hipSuccess || per_cu < 1) fprintf(stderr, "kernel_launch: occupancy query says %d\n", per_cu);
        (void)hipGetLastError();
        grid = cus;
    }
    if (grid < 0) return;
    if (hipMemsetAsync((char*)d_ws + WS_CTL, 0, CTL_BYTES, stream) != hipSuccess) return;
    Args a{};
    for (int i = 0; i < 22; ++i) a.in[i] = (const float*)d_in[i];
    a.out = (float*)d_out; a.ws = (unsigned char*)d_ws;
#if MK_SPLIT
    for (int p = 0; p < NPHASE; ++p) { a.ph_lo = p; a.ph_hi = p + 1; hipLaunchKernelGGL(fwd, dim3(grid), dim3(NTHREADS), LDS_TOTAL, stream, a); }
#else
    a.ph_lo = 0; a.ph_hi = NPHASE;
    hipLaunchKernelGGL(fwd, dim3(grid), dim3(NTHREADS), LDS_TOTAL, stream, a);
#endif
}
```

```cpp
#include <hip/hip_runtime.h>
#include <stdint.h>
#include <stdio.h>

#define LAS __attribute__((address_space(3)))
typedef unsigned short bf16_t;
typedef short bf16x8 __attribute__((ext_vector_type(8)));
typedef short s16x4 __attribute__((ext_vector_type(4)));
typedef float f32x4 __attribute__((ext_vector_type(4)));
typedef float f32x16 __attribute__((ext_vector_type(16)));
typedef unsigned u32x4 __attribute__((ext_vector_type(4)));
typedef unsigned u32x2 __attribute__((ext_vector_type(2)));

constexpr int D = 2048, NB = 4, TSEQ = 2048, NCTXB = 256;
constexpr int NLAT = NB * TSEQ;
constexpr int NCTX = NB * NCTXB;
constexpr int NROW = NLAT + NCTX;
constexpr int F_IN = 13328, NP = 13568;
constexpr int NE = 32;
constexpr int KVLEN = TSEQ + NCTXB;
constexpr int NTHREADS = 512;
#ifndef REP_MASK
#define REP_MASK 0
#endif
constexpr float EPS = 1e-6f;

constexpr size_t al256(size_t x) { return (x + 255) & ~(size_t)255; }
constexpr size_t WS_CTL   = 0;
constexpr size_t CTL_BYTES = 65536;
constexpr size_t WS_MOD   = WS_CTL + CTL_BYTES;
constexpr size_t WS_BINP  = al256(WS_MOD + 5 * 12288 * 4);
constexpr size_t WS_WTIN  = al256(WS_BINP + NP * 4);
constexpr size_t WS_WTBRM = al256(WS_WTIN + (size_t)NP * D * 2);
constexpr size_t WS_WTBRA = WS_WTBRM + (size_t)D * D * 2;
constexpr size_t WS_WTOUT = WS_WTBRA + (size_t)D * D * 2;
constexpr size_t WS_WTGU  = WS_WTOUT + (size_t)D * D * 2;
constexpr size_t WS_WTDN  = WS_WTGU + (size_t)NE * 4096 * D;
constexpr size_t WS_U     = WS_WTDN + (size_t)NE * D * D;
constexpr size_t WS_PM    = WS_U + (size_t)NROW * D * 2;
constexpr size_t WS_GATES = WS_PM + (size_t)NROW * 6144 * 2;
constexpr size_t WS_AQ    = al256(WS_GATES + (size_t)NROW * 16 * 4);
constexpr size_t WS_AK    = WS_AQ + (size_t)NLAT * D * 2;
constexpr size_t WS_VV    = WS_AK + (size_t)NROW * 512 * 2;
constexpr size_t WS_KR    = WS_VV + (size_t)NROW * 512 * 2;
constexpr size_t WS_QR    = WS_KR + (size_t)NROW * 512 * 2;
constexpr size_t WS_MG    = WS_QR + (size_t)NLAT * D * 2;
constexpr size_t WS_AO    = WS_MG + (size_t)NLAT * 4096 * 2;
constexpr size_t WS_HF    = WS_AO + (size_t)NLAT * D * 2;
constexpr size_t WS_HB    = WS_HF + (size_t)NLAT * D * 2;
constexpr size_t WS_MX    = WS_HB + (size_t)NLAT * D * 2;
constexpr size_t WS_MRG   = WS_MX + (size_t)NLAT * D * 2;
constexpr size_t WS_U2    = WS_MRG + (size_t)NLAT * D * 2;
constexpr size_t WS_TOPE  = WS_U2 + (size_t)NLAT * D;
constexpr size_t WS_TOPP  = WS_TOPE + (size_t)NLAT * 4 * 4;
constexpr size_t WS_TOPW  = WS_TOPP + (size_t)NLAT * 4 * 4;
constexpr size_t WS_LIST  = WS_TOPW + (size_t)NLAT * 4 * 4;
constexpr int    MAXROWS  = 40960;
constexpr size_t WS_HID   = WS_LIST + (size_t)NE * NLAT * 4;
constexpr size_t WS_Y     = WS_HID + (size_t)MAXROWS * D;
constexpr size_t WS_WTIN8 = WS_Y + (size_t)MAXROWS * D * 2;
constexpr size_t WS_U8    = WS_WTIN8 + (size_t)11264 * D;
constexpr size_t WS_W8BRM = WS_U8 + (size_t)NROW * D;
constexpr size_t WS_W8BRA = WS_W8BRM + (size_t)D * D;
constexpr size_t WS_W8OUT = WS_W8BRA + (size_t)D * D;
constexpr size_t WS_MX8   = WS_W8OUT + (size_t)D * D;
constexpr size_t WS_AO8   = WS_MX8 + (size_t)NLAT * D;
constexpr size_t WS_MRG8  = WS_AO8 + (size_t)NLAT * D;
constexpr size_t WS_ROPE  = WS_MRG8 + (size_t)NLAT * D;
constexpr size_t WS_HX1   = WS_ROPE + 4096 * 4;
constexpr size_t WS_END   = WS_HX1 + (size_t)NLAT * D * 2;

constexpr int CW_BAR = 0;
constexpr int CW_CNT = 4096;

constexpr int LDS_TOTAL = 144 * 1024;
constexpr int XS_OFF    = 136 * 1024;
constexpr int MISC_OFF  = 135 * 1024;

__device__ __forceinline__ unsigned cvt_pk_bf16(float lo, float hi) { unsigned r; asm volatile("v_cvt_pk_bf16_f32 %0, %1, %2" : "=v"(r) : "v"(lo), "v"(hi)); return r; }
__device__ __forceinline__ float bf_lo(unsigned w) { return __uint_as_float(w << 16); }
__device__ __forceinline__ float bf_hi(unsigned w) { return __uint_as_float(w & 0xffff0000u); }
__device__ __forceinline__ float bf_s(unsigned short h) { return __uint_as_float(((unsigned)h) << 16); }
__device__ __forceinline__ float wave_sum(float v) {
    v += __int_as_float(__builtin_amdgcn_update_dpp(0, __float_as_int(v), 0xB1, 0xf, 0xf, false));
    v += __int_as_float(__builtin_amdgcn_update_dpp(0, __float_as_int(v), 0x4E, 0xf, 0xf, false));
    v += __int_as_float(__builtin_amdgcn_update_dpp(0, __float_as_int(v), 0x141, 0xf, 0xf, false));
    v += __int_as_float(__builtin_amdgcn_update_dpp(0, __float_as_int(v), 0x140, 0xf, 0xf, false));
    v += __int_as_float(__builtin_amdgcn_update_dpp(0, __float_as_int(v), 0x142, 0xa, 0xf, false));
    v += __int_as_float(__builtin_amdgcn_update_dpp(0, __float_as_int(v), 0x143, 0xc, 0xf, false));
    return __int_as_float(__builtin_amdgcn_readlane(__float_as_int(v), 63));
}
__device__ __forceinline__ float wave_max(float v) {
    v = fmaxf(v, __int_as_float(__builtin_amdgcn_update_dpp(__float_as_int(v), __float_as_int(v), 0xB1, 0xf, 0xf, false)));
    v = fmaxf(v, __int_as_float(__builtin_amdgcn_update_dpp(__float_as_int(v), __float_as_int(v), 0x4E, 0xf, 0xf, false)));
    v = fmaxf(v, __int_as_float(__builtin_amdgcn_update_dpp(__float_as_int(v), __float_as_int(v), 0x141, 0xf, 0xf, false)));
    v = fmaxf(v, __int_as_float(__builtin_amdgcn_update_dpp(__float_as_int(v), __float_as_int(v), 0x140, 0xf, 0xf, false)));
    v = fmaxf(v, __int_as_float(__builtin_amdgcn_update_dpp(__float_as_int(v), __float_as_int(v), 0x142, 0xa, 0xf, false)));
    v = fmaxf(v, __int_as_float(__builtin_amdgcn_update_dpp(__float_as_int(v), __float_as_int(v), 0x143, 0xc, 0xf, false)));
    return __int_as_float(__builtin_amdgcn_readlane(__float_as_int(v), 63));
}
__device__ __forceinline__ int lane_id_() { int l; asm volatile("v_mbcnt_lo_u32_b32 %0, -1, 0\n\tv_mbcnt_hi_u32_b32 %0, -1, %0" : "=v"(l)); return l; }
__device__ __forceinline__ float wave_scan_add(float v) {
    v += __int_as_float(__builtin_amdgcn_update_dpp(0, __float_as_int(v), 0x111, 0xf, 0xf, false));
    v += __int_as_float(__builtin_amdgcn_update_dpp(0, __float_as_int(v), 0x112, 0xf, 0xf, false));
    v += __int_as_float(__builtin_amdgcn_update_dpp(0, __float_as_int(v), 0x114, 0xf, 0xf, false));
    v += __int_as_float(__builtin_amdgcn_update_dpp(0, __float_as_int(v), 0x118, 0xf, 0xf, false));
    v += __int_as_float(__builtin_amdgcn_update_dpp(0, __float_as_int(v), 0x142, 0xa, 0xf, false));
    v += __int_as_float(__builtin_amdgcn_update_dpp(0, __float_as_int(v), 0x143, 0xc, 0xf, false));
    return v;
}
__device__ __forceinline__ float wave_scan_max(float v) {
    const int NI = (int)0xff800000u;
    v = fmaxf(v, __int_as_float(__builtin_amdgcn_update_dpp(NI, __float_as_int(v), 0x111, 0xf, 0xf, false)));
    v = fmaxf(v, __int_as_float(__builtin_amdgcn_update_dpp(NI, __float_as_int(v), 0x112, 0xf, 0xf, false)));
    v = fmaxf(v, __int_as_float(__builtin_amdgcn_update_dpp(NI, __float_as_int(v), 0x114, 0xf, 0xf, false)));
    v = fmaxf(v, __int_as_float(__builtin_amdgcn_update_dpp(NI, __float_as_int(v), 0x118, 0xf, 0xf, false)));
    v = fmaxf(v, __int_as_float(__builtin_amdgcn_update_dpp(NI, __float_as_int(v), 0x142, 0xa, 0xf, false)));
    v = fmaxf(v, __int_as_float(__builtin_amdgcn_update_dpp(NI, __float_as_int(v), 0x143, 0xc, 0xf, false)));
    return v;
}
__device__ __forceinline__ float sum8_dpp(float v) {
    v += __int_as_float(__builtin_amdgcn_update_dpp(0, __float_as_int(v), 0xB1, 0xf, 0xf, false));
    v += __int_as_float(__builtin_amdgcn_update_dpp(0, __float_as_int(v), 0x4E, 0xf, 0xf, false));
    v += __int_as_float(__builtin_amdgcn_update_dpp(0, __float_as_int(v), 0x141, 0xf, 0xf, false));
    return v;
}
__device__ __forceinline__ float sigmoidf_(float x) { return __builtin_amdgcn_rcpf(1.f + __expf(-x)); }

__device__ __forceinline__ unsigned pk4_fp8(float a, float b, float c, float d) {
    int w = 0;
    w = __builtin_amdgcn_cvt_pk_fp8_f32(a, b, w, false);
    w = __builtin_amdgcn_cvt_pk_fp8_f32(c, d, w, true);
    return (unsigned)w;
}
constexpr float WSCALE = 32.f, WINV = 1.f / 32.f;

#define XB_TMO      128
#define XB_XCNT(j)  (256  + 64 * (j))
#define XB_XSUB(j)  (1280 + 64 * (j))
#define XB_XGEN(j)  (2304 + 64 * (j))
#define XB_TOP      3328
#define XB_TOPGEN   3392
#define XCD_BAR_WORDS 3456
#define XB_SPIN_CAP (1u << 22)

__device__ __forceinline__ unsigned xb_ld(unsigned* p)              { return __hip_atomic_load(p, __ATOMIC_RELAXED, __HIP_MEMORY_SCOPE_AGENT); }
__device__ __forceinline__ unsigned xb_add(unsigned* p, unsigned v) { return __hip_atomic_fetch_add(p, v, __ATOMIC_RELAXED, __HIP_MEMORY_SCOPE_AGENT); }
__device__ __forceinline__ unsigned xb_xcc_id() { return (unsigned)__builtin_amdgcn_s_getreg((3 << 11) | 20) & 0xFu; }
#define XB_SPIN(cond, bar) do { unsigned _sp = 0; while (cond) { __builtin_amdgcn_s_sleep(1); \
    if ((++_sp & 255u) == 0u) { if (xb_ld(&(bar)[XB_TMO])) break; if (_sp > XB_SPIN_CAP) { atomicAdd(&(bar)[XB_TMO], 1u); break; } } } } while (0)

struct XcdBarrier { unsigned* bar; unsigned x; volatile LAS unsigned* st; };

__device__ __forceinline__ XcdBarrier xcd_barrier_post(unsigned* bar, volatile LAS unsigned* st, bool leader) {
    XcdBarrier b; b.bar = bar; b.x = xb_xcc_id(); b.st = st;
    if (leader) (void)xb_add(&bar[XB_XCNT(b.x)], 1u);
    return b;
}
__device__ __forceinline__ void xcd_barrier_complete(unsigned* bar, unsigned x, unsigned& nloc, unsigned& nx) {
    const unsigned G = gridDim.x * gridDim.y * gridDim.z;
    unsigned sum, cnt, mine, sp = 0u;
    for (;;) {
        sum = 0u; cnt = 0u; mine = 0u;
#pragma unroll
        for (unsigned j = 0; j < 16; ++j) { const unsigned c = xb_ld(&bar[XB_XCNT(j)]); sum += c; cnt += (c > 0u) ? 1u : 0u; mine = (j == x) ? c : mine; }
        if (sum == G) break;
        __builtin_amdgcn_s_sleep(1);
        if ((++sp & 255u) == 0u) { if (xb_ld(&bar[XB_TMO])) break; if (sp > XB_SPIN_CAP) { atomicAdd(&bar[XB_TMO], 1u); break; } }
    }
    nloc = mine > 0u ? mine : 1u; nx = cnt > 0u ? cnt : 1u;
}
__device__ __forceinline__ void xcd_barrier(const XcdBarrier& b, int wave_) {
    asm volatile("s_waitcnt vmcnt(0)" ::: "memory");
    __syncthreads();
    if (wave_ == 0 && lane_id_() == 0) {
        unsigned* bar = b.bar;
        __builtin_amdgcn_s_waitcnt(0);
        unsigned nloc = b.st[0], nx = b.st[1];
        if (nloc == 0u) { xcd_barrier_complete(bar, b.x, nloc, nx); b.st[0] = nloc; b.st[1] = nx; }
        const unsigned old = xb_add(&bar[XB_XSUB(b.x)], 1u);
        const unsigned gen = old / nloc;
        if (old + 1u == (gen + 1u) * nloc) {
            __builtin_amdgcn_fence(__ATOMIC_RELEASE, "agent");
            asm volatile("s_waitcnt vmcnt(0)" ::: "memory");
            const unsigned og = xb_add(&bar[XB_TOP], 1u);
            const unsigned tg = og / nx;
            if (og + 1u == (tg + 1u) * nx) xb_add(&bar[XB_TOPGEN], 1u);
            else XB_SPIN(xb_ld(&bar[XB_TOPGEN]) == tg, bar);
            __builtin_amdgcn_fence(__ATOMIC_ACQUIRE, "agent");
            xb_add(&bar[XB_XGEN(b.x)], 1u);
            asm volatile("s_waitcnt vmcnt(0)" ::: "memory");
        } else {
            XB_SPIN(xb_ld(&bar[XB_XGEN(b.x)]) == gen, bar);
            __builtin_amdgcn_fence(__ATOMIC_ACQUIRE, "agent");
            asm volatile("s_waitcnt vmcnt(0)" ::: "memory");
        }
    }
    __syncthreads();
}

struct Args {
    const float* in[22];
    float* out;
    unsigned char* ws;
    int ph_lo, ph_hi;
};

namespace g8 {
constexpr int BM = 256, BK = 64, HALF = 128, HTB = HALF * BK * 2, STAGE_BYTES = 8 * HTB;
__device__ __forceinline__ int lds_byte(int r, int c) { const int st = (r >> 4) * 2 + (c >> 5), rr = r & 15, cc = c & 31, ob = rr * 64 + cc * 2; return st * 1024 + (ob ^ (((ob >> 9) & 1) << 5)); }
__device__ __forceinline__ void stage_rc(int b, int& R, int& C) { const int st = b / 1024, sb = b % 1024, swz = sb ^ (((sb >> 9) & 1) << 5); R = (st >> 1) * 16 + swz / 64; C = (st & 1) * 32 + (swz % 64) / 2; }
__device__ __forceinline__ int perm32(int rho) { const int n = rho >> 4, i = rho & 15; return 8 * (i >> 2) + 4 * n + (i & 3); }

struct Unit { int pm, pn, e, mt, hm, hn; };
typedef f32x4 Acc[2][2][4][2];
typedef int v8i __attribute__((ext_vector_type(8)));
typedef int v4i __attribute__((ext_vector_type(4)));
__device__ __forceinline__ void mfma8(f32x4& acc, v8i a, v8i b, int sc) {
    (void)sc;
    asm volatile("v_mfma_f32_16x16x128_f8f6f4 %0, %1, %2, %0" : "+v"(acc) : "v"(a), "v"(b));
}
__device__ __forceinline__ v8i cat8(bf16x8 lo, bf16x8 hi) { const v4i a = __builtin_bit_cast(v4i, lo), b = __builtin_bit_cast(v4i, hi); return __builtin_shufflevector(a, b, 0, 1, 2, 3, 4, 5, 6, 7); }

template <class Epi, class Sched, class Ops, bool FP8 = false>
__device__ __forceinline__ void gemm_phase(LAS unsigned char* lds, const int RB, const Sched& S, const Ops& G, const Epi& E, const int wave_) {
    const int wid = wave_, lane = lane_id_(), tid = wid * 64 + lane, wr = wid >> 2, wc = wid & 3, fr = lane & 15, fq = lane >> 4;
    const int nt = RB / 128;
    int R0, C0, R1, C1; stage_rc(tid * 16, R0, C0); stage_rc(tid * 16 + 8192, R1, C1);
    unsigned voffB[2];
    { const int Rb0 = Epi::PERM ? ((R0 & ~31) + perm32(R0 & 31)) : R0, Rb1 = Epi::PERM ? ((R1 & ~31) + perm32(R1 & 31)) : R1;
      voffB[0] = (unsigned)(Rb0 * RB + C0 * 2); voffB[1] = (unsigned)(Rb1 * RB + C1 * 2); }
    const size_t kstep = (size_t)128;
    const size_t hstep = (size_t)HALF * RB;
    const unsigned ldsw = (unsigned)wid * 1024u;
    const int aoff = lds_byte(wr * 64 + fr, fq * 8), boff = lds_byte(wc * 32 + fr, fq * 8);
#define G8_SA(b, h) (((b) * 2 + (h)) * HTB)
#define G8_SB(b, h) ((4 + (b) * 2 + (h)) * HTB)
#define G8_STAGE2(bufoff, gbase, v0, v1) do { \
        __builtin_amdgcn_global_load_lds((const unsigned*)((const char*)(gbase) + (v0)), (LAS unsigned*)(lds + (bufoff) + ldsw), 16, 0, 0); \
        __builtin_amdgcn_global_load_lds((const unsigned*)((const char*)(gbase) + (v1)), (LAS unsigned*)(lds + (bufoff) + ldsw + 8192), 16, 0, 0); } while (0)
#define G8_LDA(dst, b, h) do { _Pragma("unroll") for (int m = 0; m < 4; ++m) _Pragma("unroll") for (int k = 0; k < 2; ++k) dst[m][k] = *(const LAS bf16x8*)(lds + G8_SA(b, h) + aoff + m * 2048 + k * 1024); } while (0)
#define G8_LDB(dst, b, h) do { _Pragma("unroll") for (int n = 0; n < 2; ++n) _Pragma("unroll") for (int k = 0; k < 2; ++k) dst[n][k] = *(const LAS bf16x8*)(lds + G8_SB(b, h) + boff + n * 2048 + k * 1024); } while (0)
#define G8_MMA(ai, bj, At, Bt) do { __builtin_amdgcn_s_setprio(1); \
        if constexpr (FP8) { _Pragma("unroll") for (int m = 0; m < 4; ++m) _Pragma("unroll") for (int n = 0; n < 2; ++n) \
            mfma8(acc[ai][bj][m][n], cat8(Bt[n][0], Bt[n][1]), cat8(At[m][0], At[m][1]), sc1_); } \
        else { _Pragma("unroll") for (int m = 0; m < 4; ++m) _Pragma("unroll") for (int n = 0; n < 2; ++n) _Pragma("unroll") for (int k = 0; k < 2; ++k) \
            acc[ai][bj][m][n] = __builtin_amdgcn_mfma_f32_16x16x32_bf16(Bt[n][k], At[m][k], acc[ai][bj][m][n], 0, 0, 0); } \
        __builtin_amdgcn_s_setprio(0); } while (0)
#define G8_WAIT_V(n) asm volatile("s_waitcnt vmcnt(" #n ")" ::: "memory")
#define G8_WAIT_L(n) asm volatile("s_waitcnt lgkmcnt(" #n ")" ::: "memory")
#define G8_BAR __builtin_amdgcn_s_barrier()
#define G8_SCHED __builtin_amdgcn_sched_barrier(0)
    Unit cur, nxt; int ui = 0;
    if (!S.next(0, cur)) return;
    int sc1_ = 0x7F7F7F7F; asm volatile("" : "+v"(sc1_));
    Acc acc;
#pragma unroll
    for (int a = 0; a < 2; ++a)
#pragma unroll
        for (int b = 0; b < 2; ++b)
#pragma unroll
            for (int m = 0; m < 4; ++m)
#pragma unroll
                for (int n = 0; n < 2; ++n) acc[a][b][m][n] = (f32x4){0.f, 0.f, 0.f, 0.f};
    bf16x8 At[4][2], B0[2][2], B1[2][2];
    const char* cA = G.a_base(cur); const char* cB = G.b_base(cur);
    unsigned c00 = G.a_voff(cur, R0, C0), c01 = G.a_voff(cur, R1, C1), c10 = G.a_voff(cur, R0 + HALF, C0), c11 = G.a_voff(cur, R1 + HALF, C1);
    unsigned n00 = c00, n01 = c01, n10 = c10, n11 = c11;
    G8_STAGE2(G8_SB(0, 0), cB, voffB[0], voffB[1]); G8_STAGE2(G8_SA(0, 0), cA, c00, c01); G8_STAGE2(G8_SB(0, 1), cB + hstep, voffB[0], voffB[1]); G8_STAGE2(G8_SA(0, 1), cA, c10, c11);
    if (wr == 1) G8_BAR;
    G8_WAIT_V(4); G8_BAR;
    G8_STAGE2(G8_SB(1, 0), cB + kstep, voffB[0], voffB[1]); G8_STAGE2(G8_SA(1, 0), cA + kstep, c00, c01); G8_STAGE2(G8_SB(1, 1), cB + hstep + kstep, voffB[0], voffB[1]);
    G8_WAIT_V(6); G8_BAR;
    for (;;) {
        const bool has_next = S.next(ui + 1, nxt);
        const bool hn_ = Sched::HM && cur.hn >= 0;
        const bool sk0_ = Sched::HM && cur.hm <= wr * 64, hm_ = Sched::HM && cur.hm <= 128 + wr * 64;
        const char* nA = has_next ? G.a_base(nxt) : cA; const char* nB = has_next ? G.b_base(nxt) : cB;
        int k00 = 0, k01 = 0, k10 = 0, k11 = 0;
        if constexpr (Ops::GATHER) {
            if (has_next) { k00 = G.a_key(nxt, R0); k01 = G.a_key(nxt, R1); k10 = G.a_key(nxt, R0 + HALF); k11 = G.a_key(nxt, R1 + HALF); }
        }
        for (int t = 0; t < nt; t += 2) {
            const bool last = (t == nt - 2);
            const char* a1 = cA + (size_t)(t + 1) * kstep;
            const char* a2 = last ? nA : cA + (size_t)(t + 2) * kstep; const char* b2 = last ? nB : cB + (size_t)(t + 2) * kstep;
            const char* a3 = a2 + kstep; const char* b3 = b2 + kstep;
            unsigned s00 = c00, s01 = c01, s10 = c10, s11 = c11;
            if constexpr (Ops::GATHER) { if (last) { asm volatile("" : "+v"(k00), "+v"(k01), "+v"(k10), "+v"(k11));
                    if (has_next) { n00 = G.a_off(k00, C0); n01 = G.a_off(k01, C1); n10 = G.a_off(k10, C0); n11 = G.a_off(k11, C1); }
                    else { n00 = c00; n01 = c01; n10 = c10; n11 = c11; }
                    s00 = n00; s01 = n01; s10 = n10; s11 = n11; } }
            if (!sk0_) { G8_LDB(B0, 0, 0); G8_SCHED; G8_LDA(At, 0, 0); }
            G8_STAGE2(G8_SA(1, 1), a1, c10, c11);
            G8_WAIT_L(8); G8_BAR; G8_WAIT_L(0); if (!sk0_) G8_MMA(0, 0, At, B0);
            G8_BAR; G8_SCHED;
            if (!(sk0_ || hn_)) G8_LDB(B1, 0, 1);
            G8_STAGE2(G8_SB(0, 0), b2, voffB[0], voffB[1]);
            G8_BAR; G8_WAIT_L(0); if (!(sk0_ || hn_)) G8_MMA(0, 1, At, B1);
            G8_BAR;
            if (!hm_) G8_LDA(At, 0, 1);
            G8_STAGE2(G8_SA(0, 0), a2, s00, s01);
            G8_BAR; G8_WAIT_L(0); if (!hm_) G8_MMA(1, 0, At, B0);
            G8_BAR; G8_SCHED;
            G8_STAGE2(G8_SB(0, 1), b2 + hstep, voffB[0], voffB[1]);
            G8_WAIT_V(6); G8_BAR; if (!(hm_ || hn_)) G8_MMA(1, 1, At, B1);
            G8_BAR;
            if (!sk0_) { G8_LDB(B0, 1, 0); G8_SCHED; G8_LDA(At, 1, 0); }
            G8_STAGE2(G8_SA(0, 1), a2, s10, s11);
            G8_WAIT_L(8); G8_BAR; G8_WAIT_L(0); if (!sk0_) G8_MMA(0, 0, At, B0);
            G8_BAR; G8_SCHED;
            if (!(sk0_ || hn_)) G8_LDB(B1, 1, 1);
            G8_STAGE2(G8_SB(1, 0), b3, voffB[0], voffB[1]);
            G8_BAR; G8_WAIT_L(0); if (!(sk0_ || hn_)) G8_MMA(0, 1, At, B1);
            G8_BAR;
            if (!hm_) G8_LDA(At, 1, 1);
            G8_STAGE2(G8_SA(1, 0), a3, s00, s01);
            G8_BAR; G8_WAIT_L(0); if (!hm_) G8_MMA(1, 0, At, B0);
            G8_BAR; G8_SCHED;
            G8_STAGE2(G8_SB(1, 1), b3 + hstep, voffB[0], voffB[1]);
            G8_WAIT_V(6); G8_BAR; if (!(hm_ || hn_)) G8_MMA(1, 1, At, B1);
            G8_BAR;
        }
        if constexpr (FP8) {
            asm volatile("s_nop 15\n\ts_nop 15" ::: "memory");
#pragma unroll
            for (int a = 0; a < 2; ++a)
#pragma unroll
                for (int b = 0; b < 2; ++b)
#pragma unroll
                    for (int m = 0; m < 4; ++m) asm volatile("" : "+v"(acc[a][b][m][0]), "+v"(acc[a][b][m][1]));
        }
        E(acc, cur, wr, wc, fr, fq);
        if (!has_next) break;
        if (!E.keep_acc(cur)) {
#pragma unroll
            for (int a = 0; a < 2; ++a)
#pragma unroll
                for (int b = 0; b < 2; ++b)
#pragma unroll
                    for (int m = 0; m < 4; ++m)
#pragma unroll
                        for (int n = 0; n < 2; ++n) acc[a][b][m][n] = (f32x4){0.f, 0.f, 0.f, 0.f};
        }
        cur = nxt; cA = nA; cB = nB; ++ui;
        if (Ops::GATHER) { c00 = n00; c01 = n01; c10 = n10; c11 = n11; }
    }
    G8_WAIT_V(0);
    if (wr == 0) G8_BAR;
    G8_BAR;
#undef G8_SA
#undef G8_SB
#undef G8_STAGE2
#undef G8_LDA
#undef G8_LDB
#undef G8_MMA
#undef G8_WAIT_V
#undef G8_WAIT_L
#undef G8_BAR
#undef G8_SCHED
}

struct OpsPlain {
    static constexpr bool GATHER = false;
    const bf16_t* A; const bf16_t* Bt; int K;
    __device__ __forceinline__ const char* a_base(const Unit& u) const { return (const char*)A + (size_t)u.pm * 256 * K * 2; }
    __device__ __forceinline__ const char* b_base(const Unit& u) const { return (const char*)Bt + (size_t)u.pn * 256 * K * 2; }
    __device__ __forceinline__ unsigned a_voff(const Unit&, int R, int C) const { return (unsigned)(R * K + C) * 2u; }
};
__device__ __forceinline__ void tile_order(int L, int nM, int nN, int& pm, int& pn) {
    const int nwg = nM * nN; int wgid = L;
    { const int q = nwg / 8, r = nwg % 8, xcd = wgid % 8, off = wgid / 8; wgid = (xcd < r ? xcd * (q + 1) : r * (q + 1) + (xcd - r) * q) + off; }
    const int nig = 8 * nN, gid = wgid / nig, fm = gid * 8, gsz = (nM - fm) < 8 ? (nM - fm) : 8;
    pm = fm + ((wgid % nig) % gsz); pn = (wgid % nig) / gsz;
}
}

struct SchedInprojA {
    static constexpr bool HM = false;
    int G, c;
    __device__ __forceinline__ bool next(int i, g8::Unit& u) const {
        const int L = i * G + c; int j;
        u.e = 0; u.mt = 0; u.hm = 256; u.hn = -1;
        if (L < 32 * 9) { g8::tile_order(L, 32, 9, u.pm, j); u.pn = j < 8 ? j : 52; return true; }
        const int Lc = L - 32 * 9;
        if (Lc >= 4 * 5) return false;
        j = Lc >> 2; u.pm = 32 + (Lc & 3); u.pn = j < 4 ? 4 + j : 52;
        return true;
    }
};
struct SchedInprojB {
    static constexpr bool HM = false;
    int G, c;
    __device__ __forceinline__ bool next(int i, g8::Unit& u) const {
        const int L = i * G + c; int j;
        u.e = 0; u.mt = 0; u.hm = 256; u.hn = -1;
        if (L < 32 * 44) { g8::tile_order(L, 32, 44, u.pm, j); u.pn = 8 + j; return true; }
        const int Lc = L - 32 * 44;
        if (Lc >= 4 * 12) return false;
        j = Lc >> 2; u.pm = 32 + (Lc & 3); u.pn = j < 8 ? 8 + j : 24 + j;
        return true;
    }
};
struct OpsPlain8 {
    static constexpr bool GATHER = false;
    const unsigned char* A; const unsigned char* Bt; int pn0;
    __device__ __forceinline__ const char* a_base(const g8::Unit& u) const { return (const char*)A + (size_t)u.pm * 256 * D; }
    __device__ __forceinline__ const char* b_base(const g8::Unit& u) const { return (const char*)Bt + (size_t)(u.pn - pn0) * 256 * D; }
    __device__ __forceinline__ unsigned a_voff(const g8::Unit&, int R, int C) const { return (unsigned)(R * D + C * 2); }
};
template <bool HN>
struct EpiInprojT {
    static constexpr bool PERM = true;
    bf16_t* PM; bf16_t* QR; bf16_t* KR; bf16_t* VV; unsigned char* MG; unsigned char* OG8; float* GATES; const float* bias; float accs;
    const float* g_q; const float* g_k; const float* ROPE; LAS unsigned char* lds;
    __device__ __forceinline__ bool keep_acc(const g8::Unit&) const { return false; }
    __device__ __forceinline__ void operator()(const g8::Acc& acc, const g8::Unit& u, int wr, int wc, int fr, int fq) const {
        const int row0 = u.pm * 256 + wr * 64 + fr, pn = u.pn;
        const int cl0 = wc * 32 + 8 * fq;
        const float* bp = bias + pn * 256 + cl0;
        if (pn == 52) {
            if (wc == 0 && fq < 2) {
                const f32x4 b0 = *(const f32x4*)(bp), b1 = *(const f32x4*)(bp + 4);
#pragma unroll
                for (int ai = 0; ai < 2; ++ai)
#pragma unroll
                    for (int m = 0; m < 4; ++m) {
                        float* gp = GATES + (size_t)(row0 + ai * 128 + m * 16) * 16 + 8 * fq;
                        *(f32x4*)gp = acc[ai][0][m][0] * accs + b0; *(f32x4*)(gp + 4) = acc[ai][0][m][1] * accs + b1;
                    }
            }
            return;
        }
        if constexpr (HN) {
            if (pn >= 24 && pn < 34) {
                const bool isq = pn < 32, lat = u.pm < 32;
                LAS float* xs = (LAS float*)(lds + XS_OFF);
                f32x4 bb[2][2];
#pragma unroll
                for (int bj = 0; bj < 2; ++bj) { bb[bj][0] = *(const f32x4*)(bp + bj * 128); bb[bj][1] = *(const f32x4*)(bp + bj * 128 + 4); }
#pragma unroll
                for (int bj = 0; bj < 2; ++bj)
#pragma unroll
                    for (int ai = 0; ai < 2; ++ai)
#pragma unroll
                        for (int m = 0; m < 4; ++m) {
                            const f32x4 v0 = acc[ai][bj][m][0] * accs + bb[bj][0], v1 = acc[ai][bj][m][1] * accs + bb[bj][1];
                            float ss = v0[0] * v0[0] + v0[1] * v0[1] + v0[2] * v0[2] + v0[3] * v0[3] + v1[0] * v1[0] + v1[1] * v1[1] + v1[2] * v1[2] + v1[3] * v1[3];
                            { auto r_ = __builtin_amdgcn_permlane16_swap(__float_as_uint(ss), __float_as_uint(ss), false, false); ss = __uint_as_float(r_[0]) + __uint_as_float(r_[1]); }
                            { auto r_ = __builtin_amdgcn_permlane32_swap(__float_as_uint(ss), __float_as_uint(ss), false, false); ss = __uint_as_float(r_[0]) + __uint_as_float(r_[1]); }
                            if (fq == 0) xs[(bj * 256 + ai * 128 + wr * 64 + m * 16 + fr) * 4 + wc] = ss;
                        }
                __syncthreads();
                const float* gp = (isq ? g_q : g_k) + cl0;
                const f32x4 gw0 = *(const f32x4*)gp, gw1 = *(const f32x4*)(gp + 4);
#pragma unroll
                for (int ai = 0; ai < 2; ++ai)
#pragma unroll
                    for (int m = 0; m < 4; ++m) {
                        const int row = row0 + ai * 128 + m * 16, rl = ai * 128 + wr * 64 + m * 16 + fr;
                        f32x4 c4 = (f32x4){1.f, 1.f, 1.f, 1.f}, s4 = (f32x4){0.f, 0.f, 0.f, 0.f};
                        int krow;
                        if (lat) {
                            const int t = row & 2047, pos = (cl0 < 64) ? (t >> 6) : (t & 63);
                            const float* rp = ROPE + pos * 32 + ((cl0 >> 1) & 31);
                            c4 = *(const f32x4*)rp; s4 = *(const f32x4*)(rp + 2048);
                            krow = row + (row >> 11) * 256;
                        } else { const int j = row - NLAT; krow = (j >> 8) * KVLEN + TSEQ + (j & 255); }
#pragma unroll
                        for (int bj = 0; bj < 2; ++bj) {
                            const f32x4 tot = *(const LAS f32x4*)(xs + (bj * 256 + rl) * 4);
                            const float rstd = rsqrtf((tot[0] + tot[1] + tot[2] + tot[3]) * (1.f / 128.f) + EPS);
                            const f32x4 y0 = (acc[ai][bj][m][0] * accs + bb[bj][0]) * rstd * gw0, y1 = (acc[ai][bj][m][1] * accs + bb[bj][1]) * rstd * gw1;
                            u32x4 w;
                            w.x = cvt_pk_bf16(y0[0] * c4[0] - y0[1] * s4[0], y0[0] * s4[0] + y0[1] * c4[0]);
                            w.y = cvt_pk_bf16(y0[2] * c4[1] - y0[3] * s4[1], y0[2] * s4[1] + y0[3] * c4[1]);
                            w.z = cvt_pk_bf16(y1[0] * c4[2] - y1[1] * s4[2], y1[0] * s4[2] + y1[1] * c4[2]);
                            w.w = cvt_pk_bf16(y1[2] * c4[3] - y1[3] * s4[3], y1[2] * s4[3] + y1[3] * c4[3]);
                            bf16_t* dp = isq ? QR + (size_t)row * 2048 + (pn - 24) * 256 + bj * 128 + cl0 : KR + (size_t)krow * 512 + (pn - 32) * 256 + bj * 128 + cl0;
                            *(u32x4*)dp = w;
                        }
                    }
                return;
            }
        }
        bf16_t* dst; int ldc; int mode = 0; float scale = 1.f;
        unsigned char* gdst = MG + (pn - 36) * 256; int gld = 4096;
        if (pn >= 16 && pn < 24) { dst = PM; ldc = 0; mode = 1; gdst = OG8 + (pn - 16) * 256; gld = 2048; }
        else if (pn < 24) { dst = PM + pn * 256; ldc = 6144; if (pn < 4) scale = 0.0625f; }
                else if (pn < 36) { dst = VV + (pn - 34) * 256; ldc = 512; mode = 2; }
        else { dst = PM; ldc = 0; mode = 1; }
        int rowadd = 0;
        if (mode == 2) rowadd = (u.pm < 32) ? (u.pm >> 3) * 256 : (-6144 + 2048 * (u.pm - 32));
#pragma unroll
        for (int bj = 0; bj < 2; ++bj) {
            const f32x4 b0 = *(const f32x4*)(bp + bj * 128), b1 = *(const f32x4*)(bp + bj * 128 + 4);
#pragma unroll
            for (int ai = 0; ai < 2; ++ai)
#pragma unroll
                for (int m = 0; m < 4; ++m) {
                    f32x4 v0 = (acc[ai][bj][m][0] * accs + b0) * scale, v1 = (acc[ai][bj][m][1] * accs + b1) * scale;
                    if (mode == 1) {
                        unsigned q0 = 0u, q1 = 0u;
#pragma unroll
                        for (int j = 0; j < 4; ++j) {
                            q0 = __builtin_amdgcn_cvt_pk_u8_f32(fmaxf(sigmoidf_(v0[j]) * 255.f, 1.f), j, q0);
                            q1 = __builtin_amdgcn_cvt_pk_u8_f32(fmaxf(sigmoidf_(v1[j]) * 255.f, 1.f), j, q1);
                        }
                        *(u32x2*)(gdst + (size_t)(row0 + ai * 128 + m * 16) * gld + bj * 128 + cl0) = (u32x2){q0, q1};
                        continue;
                    }
                    u32x4 w; w.x = cvt_pk_bf16(v0[0], v0[1]); w.y = cvt_pk_bf16(v0[2], v0[3]); w.z = cvt_pk_bf16(v1[0], v1[1]); w.w = cvt_pk_bf16(v1[2], v1[3]);
                    *(u32x4*)(dst + (size_t)(row0 + ai * 128 + m * 16 + rowadd) * ldc + bj * 128 + cl0) = w;
                }
        }
    }
};

struct SchedDual {
    static constexpr bool HM = false;
    int G, c;
    __device__ __forceinline__ bool next(int i, g8::Unit& u) const {
        const int L = (i >> 1) * G + c;
        if (L >= 256) return false;
        g8::tile_order(L, 32, 8, u.pm, u.pn); u.e = i & 1; u.mt = 0; u.hm = 256; u.hn = -1; return true;
    }
};
constexpr float AO_SCALE = 8.f, MRG_SCALE = 4.f;
struct OpsDual {
    static constexpr bool GATHER = false;
    const unsigned char* A0; const unsigned char* A1; const unsigned char* B0; const unsigned char* B1;
    __device__ __forceinline__ const char* a_base(const g8::Unit& u) const { return (const char*)(u.e ? A1 : A0) + (size_t)u.pm * 256 * D; }
    __device__ __forceinline__ const char* b_base(const g8::Unit& u) const { return (const char*)(u.e ? B1 : B0) + (size_t)u.pn * 256 * D; }
    __device__ __forceinline__ unsigned a_voff(const g8::Unit&, int R, int C) const { return (unsigned)(R * D + C * 2); }
};
struct EpiMerge {
    static constexpr bool PERM = true;
    const unsigned char* MG; unsigned char* OUT;
    __device__ __forceinline__ bool keep_acc(const g8::Unit& u) const { return u.e == 0; }
    __device__ __forceinline__ void operator()(g8::Acc& acc, const g8::Unit& u, int wr, int wc, int fr, int fq) const {
        const int row0 = u.pm * 256 + wr * 64 + fr, col0 = u.pn * 256 + wc * 32 + 8 * fq;
        constexpr float FS = MRG_SCALE / (WSCALE * AO_SCALE * 255.f);
#define UB4(x) (f32x4){(float)((x) & 0xffu), (float)(((x) >> 8) & 0xffu), (float)(((x) >> 16) & 0xffu), (float)((x) >> 24)}
#pragma unroll
        for (int ai = 0; ai < 2; ++ai) {
            u32x2 ga[4][2], gm[4][2];
#pragma unroll
            for (int m = 0; m < 4; ++m)
#pragma unroll
                for (int bj = 0; bj < 2; ++bj) {
                    const unsigned char* gp = MG + (size_t)(row0 + ai * 128 + m * 16) * 4096 + col0 + bj * 128;
                    ga[m][bj] = *(const u32x2*)(gp + 2048);
                    if (u.e == 0) gm[m][bj] = *(const u32x2*)gp;
                }
#pragma unroll
            for (int m = 0; m < 4; ++m) {
                const size_t row = (size_t)(row0 + ai * 128 + m * 16);
#pragma unroll
                for (int bj = 0; bj < 2; ++bj) {
                    const int col = col0 + bj * 128;
                    const f32x4 a0 = UB4(ga[m][bj].x), a1 = UB4(ga[m][bj].y);
                    if (u.e == 0) {
                        const f32x4 g0 = UB4(gm[m][bj].x), g1 = UB4(gm[m][bj].y);
                        f32x4 r0, r1;
#pragma unroll
                        for (int j = 0; j < 4; ++j) { r0[j] = g0[j] * __builtin_amdgcn_rcpf(a0[j]); r1[j] = g1[j] * __builtin_amdgcn_rcpf(a1[j]); }
                        acc[ai][bj][m][0] *= r0 * AO_SCALE; acc[ai][bj][m][1] *= r1 * AO_SCALE;
                    } else {
                        const f32x4 v0 = acc[ai][bj][m][0] * FS * a0, v1 = acc[ai][bj][m][1] * FS * a1;
                        u32x2 w; w.x = pk4_fp8(v0[0], v0[1], v0[2], v0[3]); w.y = pk4_fp8(v1[0], v1[1], v1[2], v1[3]);
                        *(u32x2*)(OUT + row * 2048 + col) = w;
                    }
                }
            }
        }
#undef UB4
    }
};

struct SchedSquare {
    static constexpr bool HM = false;
    int G, c, nM, nN;
    __device__ __forceinline__ bool next(int i, g8::Unit& u) const {
        const int L = i * G + c;
        if (L >= nM * nN) return false;
        g8::tile_order(L, nM, nN, u.pm, u.pn); u.e = 0; u.mt = 0; u.hm = 256; u.hn = -1; return true;
    }
};
struct EpiOut {
    static constexpr bool PERM = true;
    const float* X; const float* MOD; bf16_t* HX; float accs;
    __device__ __forceinline__ bool keep_acc(const g8::Unit&) const { return false; }
    __device__ __forceinline__ void operator()(const g8::Acc& acc, const g8::Unit& u, int wr, int wc, int fr, int fq) const {
        const int row0 = u.pm * 256 + wr * 64 + fr, col0 = u.pn * 256 + wc * 32 + 8 * fq;
        const float* gt = MOD + (size_t)(u.pm >> 3) * 12288 + 4096 + col0;
        f32x4 g[2][2];
#pragma unroll
        for (int bj = 0; bj < 2; ++bj)
#pragma unroll
            for (int n = 0; n < 2; ++n) g[bj][n] = *(const f32x4*)(gt + bj * 128 + n * 4) * accs;
#pragma unroll
        for (int ai = 0; ai < 2; ++ai) {
            f32x4 xv[4][2][2];
#pragma unroll
            for (int m = 0; m < 4; ++m) {
                const size_t ro = (size_t)(row0 + ai * 128 + m * 16) * 2048 + col0;
#pragma unroll
                for (int bj = 0; bj < 2; ++bj)
#pragma unroll
                    for (int n = 0; n < 2; ++n) xv[m][bj][n] = *(const f32x4*)(X + ro + bj * 128 + n * 4);
            }
#pragma unroll
            for (int m = 0; m < 4; ++m) {
                const size_t ro = (size_t)(row0 + ai * 128 + m * 16) * 2048 + col0;
#pragma unroll
                for (int bj = 0; bj < 2; ++bj) {
                    const f32x4 v0 = xv[m][bj][0] + g[bj][0] * acc[ai][bj][m][0], v1 = xv[m][bj][1] + g[bj][1] * acc[ai][bj][m][1];
                    u32x4 w; w.x = cvt_pk_bf16(v0[0], v0[1]); w.y = cvt_pk_bf16(v0[2], v0[3]); w.z = cvt_pk_bf16(v1[0], v1[1]); w.w = cvt_pk_bf16(v1[2], v1[3]);
                    *(u32x4*)(HX + ro + bj * 128) = w;
                }
            }
        }
    }
};

struct SchedMoe {
    static constexpr bool HM = true;
    int G, vcu, NT; const volatile LAS int* mstart; const volatile LAS int* texp; const volatile LAS int* ecnt; int split;
    __device__ __forceinline__ bool next(int i, g8::Unit& u) const {
        const int total = mstart[32] * NT;
        int L = i * G + vcu, hn = -1;
        if (split) {
            const int R = total / G, r = total - R * G;
            if (r > 0 && 2 * r <= G && i >= R) { if (i > R || vcu >= 2 * r) return false; L = R * G + (vcu >> 1); hn = vcu & 1; }
        }
        if (L >= total) return false;
        u.hn = hn;
        const int mg = L / NT;
        const int e = texp[mg];
        const int ms = mstart[e], nm = mstart[e + 1] - ms, local = L - ms * NT;
        u.e = e; u.mt = local % nm; u.pn = local / nm; u.pm = ms + u.mt;
        { const int left = ecnt[e] - u.mt * 256; u.hm = left < 256 ? left : 256; }
        return true;
    }
};
struct OpsMoe1 {
    static constexpr bool GATHER = true;
    const unsigned char* U2; const unsigned char* WT; const int* LIST; const volatile LAS int* ecnt;
    __device__ __forceinline__ const char* a_base(const g8::Unit&) const { return (const char*)U2; }
    __device__ __forceinline__ const char* b_base(const g8::Unit& u) const { return (const char*)WT + ((size_t)u.e * 4096 + (size_t)u.pn * 256) * D; }
    __device__ __forceinline__ int a_key(const g8::Unit& u, int R) const {
        const int n = ecnt[u.e]; int slot = u.mt * 256 + R; slot = slot < n ? slot : n - 1;
        return LIST[u.e * NLAT + slot];
    }
    __device__ __forceinline__ unsigned a_off(int tok, int C) const { return (unsigned)(tok * D + C * 2); }
    __device__ __forceinline__ unsigned a_voff(const g8::Unit& u, int R, int C) const { return a_off(a_key(u, R), C); }
};
struct EpiMoe1 {
    static constexpr bool PERM = true;
    unsigned char* HID; const float* bgu;
    __device__ __forceinline__ bool keep_acc(const g8::Unit&) const { return false; }
    __device__ __forceinline__ void operator()(const g8::Acc& acc, const g8::Unit& u, int wr, int wc, int fr, int fq) const {
        const int row0 = u.pm * 256 + wr * 64 + fr, j0 = u.pn * 128 + wc * 32 + 8 * fq;
        const float* bg = bgu + (size_t)u.e * 4096 + j0; const float* bu = bg + 2048;
        const f32x4 g0 = *(const f32x4*)bg, g1 = *(const f32x4*)(bg + 4), u0 = *(const f32x4*)bu, u1 = *(const f32x4*)(bu + 4);
#pragma unroll
        for (int ai = 0; ai < 2; ++ai) {
            if (u.hm <= ai * 128 + wr * 64) break;
#pragma unroll
            for (int m = 0; m < 4; ++m) {
                f32x4 ga = acc[ai][0][m][0] * WINV + g0, gb = acc[ai][0][m][1] * WINV + g1, ua = acc[ai][1][m][0] * WINV + u0, ub = acc[ai][1][m][1] * WINV + u1;
                f32x4 ha, hb;
#pragma unroll
                for (int j = 0; j < 4; ++j) {
                    const float gt = fminf(ga[j], 7.f), up = fminf(fmaxf(ua[j], -7.f), 7.f);
                    ha[j] = (up + 1.f) * gt * sigmoidf_(1.702f * gt);
                    const float gt2 = fminf(gb[j], 7.f), up2 = fminf(fmaxf(ub[j], -7.f), 7.f);
                    hb[j] = (up2 + 1.f) * gt2 * sigmoidf_(1.702f * gt2);
                }
                u32x2 w; w.x = pk4_fp8(ha[0], ha[1], ha[2], ha[3]); w.y = pk4_fp8(hb[0], hb[1], hb[2], hb[3]);
                *(u32x2*)(HID + (size_t)(row0 + ai * 128 + m * 16) * 2048 + j0) = w;
            }
        }
    }
};
struct OpsMoe2 {
    static constexpr bool GATHER = false;
    const unsigned char* HID; const unsigned char* WT;
    __device__ __forceinline__ const char* a_base(const g8::Unit& u) const { return (const char*)HID + (size_t)u.pm * 256 * D; }
    __device__ __forceinline__ const char* b_base(const g8::Unit& u) const { return (const char*)WT + ((size_t)u.e * 2048 + (size_t)u.pn * 256 + (u.hn > 0 ? 128 : 0)) * D; }
    __device__ __forceinline__ unsigned a_voff(const g8::Unit&, int R, int C) const { return (unsigned)(R * D + C * 2); }
};
constexpr float Y_SCALE = 8.f;
struct EpiMoe2 {
    static constexpr bool PERM = true;
    bf16_t* Y; const float* bdn;
    __device__ __forceinline__ bool keep_acc(const g8::Unit&) const { return false; }
    __device__ __forceinline__ void operator()(const g8::Acc& acc, const g8::Unit& u, int wr, int wc, int fr, int fq) const {
        const int row0 = u.pm * 256 + wr * 64 + fr, col0 = u.pn * 256 + (u.hn > 0 ? 128 : 0) + wc * 32 + 8 * fq;
        const float* bp = bdn + (size_t)u.e * 2048 + col0;
#pragma unroll
        for (int bj = 0; bj < 2; ++bj) {
            if (bj == 1 && u.hn >= 0) break;
            const f32x4 b0 = *(const f32x4*)(bp + bj * 128), b1 = *(const f32x4*)(bp + bj * 128 + 4);
#pragma unroll
            for (int ai = 0; ai < 2; ++ai) {
                if (u.hm <= ai * 128 + wr * 64) break;
#pragma unroll
                for (int m = 0; m < 4; ++m) {
                    const f32x4 v0 = (acc[ai][bj][m][0] * WINV + b0) * Y_SCALE, v1 = (acc[ai][bj][m][1] * WINV + b1) * Y_SCALE;
                    u32x2 w; w.x = pk4_fp8(v0[0], v0[1], v0[2], v0[3]); w.y = pk4_fp8(v1[0], v1[1], v1[2], v1[3]);
                    *(u32x2*)((unsigned char*)Y + (size_t)(row0 + ai * 128 + m * 16) * 2048 + col0 + bj * 128) = w;
                }
            }
        }
    }
};

namespace att {
constexpr int DH = 128, NW = 8, QBLK = 32, KVBLK = 64;
constexpr float SCALE = 0.088388347648318440f;
constexpr float THR = 8.f;
constexpr int LDQ = 2048, LDK = 512, LDO = 2048;
constexpr size_t SHM_V = KVBLK * DH * 2, SHM_K = KVBLK * DH * 2;
#define KSWZ(row, colB) ((row) * 256 + ((colB) ^ (((row) & 7) << 4)))
#define SBAR() __builtin_amdgcn_sched_barrier(0)
__device__ __forceinline__ int crow(int r, int hi) { return (r & 3) + 8 * (r >> 2) + 4 * hi; }
__device__ __forceinline__ void partialSM(f32x16& p0, f32x16& p1, float& m_reg, float& mn, float& alpha) {
  constexpr float C = SCALE * 1.4426950408889634f;
  float pmax = p0[0];
#pragma unroll
  for (int r = 1; r < 16; ++r) pmax = fmaxf(pmax, p0[r]);
#pragma unroll
  for (int r = 0; r < 16; ++r) pmax = fmaxf(pmax, p1[r]);
  { auto rr = __builtin_amdgcn_permlane32_swap(__float_as_uint(pmax), __float_as_uint(pmax), false, false);
    pmax = fmaxf(__uint_as_float(rr[0]), __uint_as_float(rr[1])); }
  if (__builtin_expect(__all(pmax - m_reg <= THR / SCALE), 1)) { mn = m_reg; alpha = 1.f; }
  else { mn = fmaxf(m_reg, pmax); alpha = __builtin_amdgcn_exp2f((m_reg - mn) * C); m_reg = mn; }
  float mnC = -mn * C;
#pragma unroll
  for (int r = 0; r < 16; ++r) p0[r] = fmaf(p0[r], C, mnC);
#pragma unroll
  for (int r = 0; r < 16; ++r) p1[r] = fmaf(p1[r], C, mnC);
#pragma unroll
  for (int r = 0; r < 16; ++r) p0[r] = __builtin_amdgcn_exp2f(p0[r]);
}
__device__ __forceinline__ void finishSM(f32x16& p0, f32x16& p1, float alpha, float& l_reg, bf16x8& pa0, bf16x8& pa1, bf16x8& pa2, bf16x8& pa3) {
#pragma unroll
  for (int r = 0; r < 16; ++r) p1[r] = __builtin_amdgcn_exp2f(p1[r]);
  float ps = 0;
#pragma unroll
  for (int r = 0; r < 16; ++r) ps += p0[r];
#pragma unroll
  for (int r = 0; r < 16; ++r) ps += p1[r];
  { auto rr = __builtin_amdgcn_permlane32_swap(__float_as_uint(ps), __float_as_uint(ps), false, false);
    ps = __uint_as_float(rr[0]) + __uint_as_float(rr[1]); }
  l_reg = l_reg * alpha + ps;
#define PK4(P, BASE, OUT) do { unsigned a0 = cvt_pk_bf16(P[BASE + 0], P[BASE + 1]), a1 = cvt_pk_bf16(P[BASE + 2], P[BASE + 3]);   \
    unsigned b0 = cvt_pk_bf16(P[BASE + 4], P[BASE + 5]), b1 = cvt_pk_bf16(P[BASE + 6], P[BASE + 7]);                              \
    auto r0 = __builtin_amdgcn_permlane32_swap(a0, b0, false, false); auto r1 = __builtin_amdgcn_permlane32_swap(a1, b1, false, false); \
    u32x4 w = {r0[0], r1[0], r0[1], r1[1]}; OUT = *reinterpret_cast<bf16x8*>(&w); } while (0)
  PK4(p0, 0, pa0); PK4(p0, 8, pa1); PK4(p1, 0, pa2); PK4(p1, 8, pa3);
#undef PK4
}
__device__ __forceinline__ void qkt(f32x16& p0, f32x16& p1, const bf16_t* Ks, const bf16x8* qr, int r32, int hi) {
  p0 = f32x16{}; p1 = f32x16{};
#pragma unroll
  for (int d0 = 0; d0 < 8; ++d0) { int cb = (d0 * 16 + hi * 8) * 2;
    bf16x8 b0 = *reinterpret_cast<const bf16x8*>((const char*)Ks + KSWZ(r32, cb));
    bf16x8 b1 = *reinterpret_cast<const bf16x8*>((const char*)Ks + KSWZ(32 + r32, cb));
    p0 = __builtin_amdgcn_mfma_f32_32x32x16_bf16(b0, qr[d0], p0, 0, 0, 0);
    p1 = __builtin_amdgcn_mfma_f32_32x32x16_bf16(b1, qr[d0], p1, 0, 0, 0); }
}
__device__ __forceinline__ int v_st(int k, int c) { const int kk = (k & ~0xC) | ((k & 4) << 1) | ((k & 8) >> 1); return ((kk >> 3) * 4 + (c >> 5)) * 512 + ((kk & 7) * 32 + (c & 31)) * 2; }
__device__ __forceinline__ int v_rd_base(int lane) { return ((lane & 3) << 3) | (((lane >> 2) & 3) << 6) | (((lane >> 4) & 1) << 5) | (((lane >> 5) & 1) << 8); }
constexpr int v_rd_off(int d0, int ks, int half) { return d0 * 512 + ks * 4096 + half * 2048; }
template <int OFF> __device__ __forceinline__ s16x4 tr_read(int vb) {
  s16x4 r; asm volatile("ds_read_b64_tr_b16 %0, %1 offset:%2" : "=&v"(r) : "v"(vb), "i"(OFF) : "memory"); return r;
}
template <int D0> __device__ __forceinline__ void pv_one(f32x16& od, int vb, bf16x8 pa0, bf16x8 pa1, bf16x8 pa2, bf16x8 pa3) {
  const s16x4 l0 = tr_read<v_rd_off(D0, 0, 0)>(vb), h0 = tr_read<v_rd_off(D0, 0, 1)>(vb), l1 = tr_read<v_rd_off(D0, 1, 0)>(vb), h1 = tr_read<v_rd_off(D0, 1, 1)>(vb);
  const s16x4 l2 = tr_read<v_rd_off(D0, 2, 0)>(vb), h2 = tr_read<v_rd_off(D0, 2, 1)>(vb), l3 = tr_read<v_rd_off(D0, 3, 0)>(vb), h3 = tr_read<v_rd_off(D0, 3, 1)>(vb);
  asm volatile("s_waitcnt lgkmcnt(0)" ::: "memory"); SBAR();
#define PK(L, H) (bf16x8){L[0], L[1], L[2], L[3], H[0], H[1], H[2], H[3]}
  od = __builtin_amdgcn_mfma_f32_32x32x16_bf16(pa0, PK(l0, h0), od, 0, 0, 0);
  od = __builtin_amdgcn_mfma_f32_32x32x16_bf16(pa1, PK(l1, h1), od, 0, 0, 0);
  od = __builtin_amdgcn_mfma_f32_32x32x16_bf16(pa2, PK(l2, h2), od, 0, 0, 0);
  od = __builtin_amdgcn_mfma_f32_32x32x16_bf16(pa3, PK(l3, h3), od, 0, 0, 0);
#undef PK
}
__device__ __forceinline__ void pv_d0(f32x16* o, int vb, bf16x8 pa0, bf16x8 pa1, bf16x8 pa2, bf16x8 pa3) {
  pv_one<0>(o[0], vb, pa0, pa1, pa2, pa3); pv_one<1>(o[1], vb, pa0, pa1, pa2, pa3); pv_one<2>(o[2], vb, pa0, pa1, pa2, pa3); pv_one<3>(o[3], vb, pa0, pa1, pa2, pa3);
}
__device__ __forceinline__ void attn_dense_body(const bf16_t* __restrict__ Qb, const bf16_t* __restrict__ Kh, const bf16_t* __restrict__ Vh,
                                                unsigned char* __restrict__ Ob, int seq, char* lds, LAS unsigned char* lds3, const int wave_) {
  const int wid = wave_, lane = lane_id_(), tid = wid * 64 + lane, r32 = lane & 31, hi = lane >> 5;
  bf16_t* V_lds = (bf16_t*)lds; bf16_t* K_lds = (bf16_t*)(lds + 2 * SHM_V);
  float* ws = (float*)(lds + 2 * SHM_V + 2 * SHM_K) + wid * 64; float* li_l = ws; float* al_l = ws + 32;
  float m_reg = -1e30f, l_reg = 0; f32x16 o[4] = {}; bf16x8 qr[8];
  const bf16_t* Qw = Qb + (long)(wid * QBLK + r32) * LDQ + hi * 8;
#pragma unroll
  for (int d0 = 0; d0 < 8; ++d0) qr[d0] = *reinterpret_cast<const bf16x8*>(Qw + d0 * 16);
  const int sr = tid >> 4, sc = (tid & 15) * 8, vst0 = v_st(sr, sc), vst1 = v_st(32 + sr, sc);
  const int vb0 = (int)(uintptr_t)V_lds + v_rd_base(lane);
  struct { bf16x8 vs0, vs1, ks0, ks1; } sr_[2];
#define SLOAD(i, k0) do { sr_[i].vs0 = *reinterpret_cast<const bf16x8*>(&Vh[(long)((k0) + sr) * LDK + sc]); sr_[i].vs1 = *reinterpret_cast<const bf16x8*>(&Vh[(long)((k0) + 32 + sr) * LDK + sc]); \
    sr_[i].ks0 = *reinterpret_cast<const bf16x8*>(&Kh[(long)((k0) + sr) * LDK + sc]); sr_[i].ks1 = *reinterpret_cast<const bf16x8*>(&Kh[(long)((k0) + 32 + sr) * LDK + sc]); } while (0)
#define SWRITE(b, i) do { *(bf16x8*)((char*)V_lds + (b) * SHM_V + vst0) = sr_[i].vs0;          \
    *(bf16x8*)((char*)V_lds + (b) * SHM_V + vst1) = sr_[i].vs1; int kc = sc * 2;               \
    *(bf16x8*)((char*)K_lds + (b) * SHM_K + KSWZ(sr, kc)) = sr_[i].ks0;                       \
    *(bf16x8*)((char*)K_lds + (b) * SHM_K + KSWZ(32 + sr, kc)) = sr_[i].ks1; } while (0)
#define SWAIT() do { asm volatile("s_waitcnt vmcnt(4)" ::: "memory"); } while (0)
#define RESC(a) do { if (__any((a) < 1.f)) { if (hi == 0) al_l[r32] = (a); asm volatile("s_waitcnt lgkmcnt(0)" ::: "memory"); \
    _Pragma("unroll") for (int d = 0; d < 4; ++d) _Pragma("unroll") for (int r = 0; r < 16; ++r) o[d][r] *= al_l[crow(r, hi)]; } } while (0)
  f32x16 pA0, pA1, pB0, pB1; float mnA, mnB, alA, alB; bf16x8 pa0, pa1, pa2, pa3; const int NT = seq / KVBLK;
  constexpr int SE = 0, SO = 1;
  SLOAD(SE, 0); asm volatile("s_waitcnt vmcnt(0)" ::: "memory"); SWRITE(0, SE); __syncthreads();
  qkt(pA0, pA1, K_lds, qr, r32, hi); partialSM(pA0, pA1, m_reg, mnA, alA);
  SLOAD(SO, KVBLK); if (2 < NT) SLOAD(SE, 2 * KVBLK);
  SWAIT(); SWRITE(1, SO); __syncthreads();
  for (int j = 1; j + 1 < NT; j += 2) {
    SBAR(); qkt(pB0, pB1, (bf16_t*)((char*)K_lds + SHM_K), qr, r32, hi);
    finishSM(pA0, pA1, alA, l_reg, pa0, pa1, pa2, pa3); SBAR();
    SLOAD(SO, (j + 2) * KVBLK); SBAR();
    pv_d0(o, vb0, pa0, pa1, pa2, pa3); partialSM(pB0, pB1, m_reg, mnB, alB);
    __syncthreads(); SWAIT(); SWRITE(0, SE);
    RESC(alB); __syncthreads();
    SBAR(); qkt(pA0, pA1, K_lds, qr, r32, hi);
    finishSM(pB0, pB1, alB, l_reg, pa0, pa1, pa2, pa3); SBAR();
    if (j + 3 < NT) SLOAD(SE, (j + 3) * KVBLK); SBAR();
    pv_d0(o, vb0 + (int)SHM_V, pa0, pa1, pa2, pa3); partialSM(pA0, pA1, m_reg, mnA, alA);
    __syncthreads(); SWAIT(); SWRITE(1, SO);
    RESC(alA); __syncthreads();
  }
  SBAR(); qkt(pB0, pB1, (bf16_t*)((char*)K_lds + SHM_K), qr, r32, hi);
  finishSM(pA0, pA1, alA, l_reg, pa0, pa1, pa2, pa3); SBAR();
  pv_d0(o, vb0, pa0, pa1, pa2, pa3); partialSM(pB0, pB1, m_reg, mnB, alB);
  __syncthreads(); RESC(alB);
  finishSM(pB0, pB1, alB, l_reg, pa0, pa1, pa2, pa3); SBAR();
  pv_d0(o, vb0 + (int)SHM_V, pa0, pa1, pa2, pa3);
  if (hi == 0) li_l[r32] = l_reg; asm volatile("s_waitcnt lgkmcnt(0)" ::: "memory");
  float rli[16];
#pragma unroll
  for (int r = 0; r < 16; ++r) rli[r] = __builtin_amdgcn_rcpf(li_l[crow(r, hi)]);
  LAS unsigned char* stg = lds3 + 68 * 1024 + wid * 8192;
#pragma unroll
  for (int r = 0; r < 16; ++r) { const int orow = crow(r, hi);
#pragma unroll
    for (int d0 = 0; d0 < 4; ++d0) *(LAS unsigned short*)(stg + orow * 256 + (d0 * 32 + r32) * 2) = (unsigned short)(cvt_pk_bf16(o[d0][r] * rli[r], 0.f) & 0xffffu); }
  unsigned char* Ow = Ob + (long)(wid * QBLK) * LDO;
#pragma unroll
  for (int j = 0; j < 4; ++j) {
    const int idx = lane + 64 * j, orow = idx >> 3, ch = idx & 7;
    const u32x4 a = *(const LAS u32x4*)(stg + orow * 256 + ch * 32), b = *(const LAS u32x4*)(stg + orow * 256 + ch * 32 + 16);
    u32x4 w;
    w.x = pk4_fp8(bf_lo(a.x) * AO_SCALE, bf_hi(a.x) * AO_SCALE, bf_lo(a.y) * AO_SCALE, bf_hi(a.y) * AO_SCALE); w.y = pk4_fp8(bf_lo(a.z) * AO_SCALE, bf_hi(a.z) * AO_SCALE, bf_lo(a.w) * AO_SCALE, bf_hi(a.w) * AO_SCALE);
    w.z = pk4_fp8(bf_lo(b.x) * AO_SCALE, bf_hi(b.x) * AO_SCALE, bf_lo(b.y) * AO_SCALE, bf_hi(b.y) * AO_SCALE); w.w = pk4_fp8(bf_lo(b.z) * AO_SCALE, bf_hi(b.z) * AO_SCALE, bf_lo(b.w) * AO_SCALE, bf_hi(b.w) * AO_SCALE);
    *(u32x4*)(Ow + (long)orow * LDO + ch * 16) = w;
  }
  __syncthreads();
#undef SLOAD
#undef SWRITE
#undef SWAIT
#undef RESC
}
}

namespace ml {
constexpr int QS = 0, KS = 33792, VS = 67584, VWS = 76800, SS = 86016, CTS = 95232, NV = 129024;
constexpr int SC_A = 130048, SC_M = SC_A + 256, SC_WI = SC_M + 256, SC_TH = SC_WI + 256, SC_WS = SC_TH + 256, SC_DEN = SC_WS + 256, SC_WC = SC_DEN + 256, NV2 = SC_WC + 256;
constexpr int RQ = 528, RV = 144;

__device__ __forceinline__ bf16x8 tr_pair(const LAS unsigned char* p, int rowstride4) {
    const s16x4 lo = __builtin_amdgcn_ds_read_tr16_b64_v4i16((LAS s16x4*)p);
    const s16x4 hi = __builtin_amdgcn_ds_read_tr16_b64_v4i16((LAS s16x4*)(p + rowstride4));
    return (bf16x8){lo[0], lo[1], lo[2], lo[3], hi[0], hi[1], hi[2], hi[3]};
}

struct Conv { const float* w_gu; const float* w_dn; unsigned char* WTGU; unsigned char* WTDN; int t, nw; };
constexpr int T_GU = NE * 16 * 128, T_DN = NE * 16 * 64, T_CONV = T_GU + T_DN;
#define CV_ISSUE() do { if (cvs.t < T_CONV) { const float* sp_; \
        if (cvs.t < T_GU) { const int e_ = cvs.t >> 11, r_ = cvs.t & 2047, nb_ = r_ & 127, kb_ = r_ >> 7; sp_ = cvs.w_gu + (size_t)e_ * 2048 * 4096 + (size_t)(kb_ * 128 + (lane >> 3) * 16) * 4096 + nb_ * 32 + (lane & 7) * 4; \
            _Pragma("unroll") for (int kk = 0; kk < 16; ++kk) cv[kk] = __builtin_nontemporal_load((const f32x4*)(sp_ + (size_t)kk * 4096)); } \
        else { const int q_ = cvs.t - T_GU, e_ = q_ >> 10, r_ = q_ & 1023, nb_ = r_ & 63, kb_ = r_ >> 6; sp_ = cvs.w_dn + (size_t)e_ * 2048 * 2048 + (size_t)(kb_ * 128 + (lane >> 3) * 16) * 2048 + nb_ * 32 + (lane & 7) * 4; \
            _Pragma("unroll") for (int kk = 0; kk < 16; ++kk) cv[kk] = __builtin_nontemporal_load((const f32x4*)(sp_ + (size_t)kk * 2048)); } } } while (0)
#define CV_FINISH() do { if (cvs.t < T_CONV) { unsigned char* dp_; \
        if (cvs.t < T_GU) { const int e_ = cvs.t >> 11, r_ = cvs.t & 2047, nb_ = r_ & 127, kb_ = r_ >> 7, n_ = nb_ * 32 + (lane & 7) * 4, j_ = n_ & 2047, nd_ = (j_ >> 7) * 256 + ((n_ >> 11) << 7) + (j_ & 127); \
            dp_ = cvs.WTGU + ((size_t)e_ * 4096 + nd_) * D + kb_ * 128 + (lane >> 3) * 16; } \
        else { const int q_ = cvs.t - T_GU, e_ = q_ >> 10, r_ = q_ & 1023, nb_ = r_ & 63, kb_ = r_ >> 6, n_ = nb_ * 32 + (lane & 7) * 4; \
            dp_ = cvs.WTDN + ((size_t)e_ * 2048 + n_) * D + kb_ * 128 + (lane >> 3) * 16; } \
        _Pragma("unroll") for (int j = 0; j < 4; ++j) { u32x4 w_; \
            w_.x = pk4_fp8(cv[0][j] * WSCALE, cv[1][j] * WSCALE, cv[2][j] * WSCALE, cv[3][j] * WSCALE); \
            w_.y = pk4_fp8(cv[4][j] * WSCALE, cv[5][j] * WSCALE, cv[6][j] * WSCALE, cv[7][j] * WSCALE); \
            w_.z = pk4_fp8(cv[8][j] * WSCALE, cv[9][j] * WSCALE, cv[10][j] * WSCALE, cv[11][j] * WSCALE); \
            w_.w = pk4_fp8(cv[12][j] * WSCALE, cv[13][j] * WSCALE, cv[14][j] * WSCALE, cv[15][j] * WSCALE); \
            *(u32x4*)(dp_ + (size_t)j * D) = w_; } } cvs.t += cvs.nw; } while (0)

__device__ __forceinline__ void mlstm_unit(LAS unsigned char* lds, const bf16_t* __restrict__ PM, const float* __restrict__ GATES, bf16_t* __restrict__ Hout,
                                           int b, int h, int dir, int vs, Conv& cvs, const int wave_) {
    f32x4 cv[16];
    const int w = wave_, lane = lane_id_(), tid = w * 64 + lane, g = lane >> 4, i16 = lane & 15, q4 = i16 >> 2, p4 = lane & 3;
    const int sr = tid >> 3, c8 = tid & 7;
    f32x4 accC[2][4];
#pragma unroll
    for (int a = 0; a < 2; ++a)
#pragma unroll
        for (int v = 0; v < 4; ++v) accC[a][v] = (f32x4){0.f, 0.f, 0.f, 0.f};
    if (tid < 256) *(LAS float*)(lds + NV + tid * 4) = 0.f;
    float m_in = 0.f;
    bool pend_b = false;
    u32x4 rq[4], rk[4], rv; float g_i = 0.f, g_f = 0.f;
    const int gi_col = (dir ? 8 : 0) + h, gf_col = (dir ? 12 : 4) + h;
#define ML_ROW0(ci) ((ci) < 4 ? (NLAT + b * NCTXB + (dir ? (NCTXB - 64 * ((ci) + 1)) : 64 * (ci))) : (b * TSEQ + (dir ? (TSEQ - 64 * ((ci) - 3)) : 64 * ((ci) - 4))))
#define ML_LOAD(ci) do { const int _r0 = ML_ROW0(ci); const bf16_t* _rp = PM + (size_t)(_r0 + sr) * 6144; \
        _Pragma("unroll") for (int j = 0; j < 4; ++j) rk[j] = *(const u32x4*)(_rp + 1024 + h * 256 + (j * 8 + c8) * 8); \
        rv = *(const u32x4*)(_rp + 2048 + h * 512 + vs * 64 + c8 * 8); \
        if ((ci) >= 4) { _Pragma("unroll") for (int j = 0; j < 4; ++j) rq[j] = *(const u32x4*)(_rp + h * 256 + (j * 8 + c8) * 8); } \
        if (w == 0) { const int _p = dir ? 63 - lane : lane; g_i = GATES[(size_t)(_r0 + _p) * 16 + gi_col]; g_f = GATES[(size_t)(_r0 + _p) * 16 + gf_col]; } } while (0)
    ML_LOAD(0);
#pragma unroll 1
    for (int ci = 0; ci < 36; ++ci) {
        const bool lat = ci >= 4;
        const int row0 = ML_ROW0(ci);
#pragma unroll
        for (int j = 0; j < 4; ++j) *(LAS u32x4*)(lds + KS + sr * RQ + (j * 8 + c8) * 16) = rk[j];
        *(LAS u32x4*)(lds + VS + sr * RV + c8 * 16) = rv;
        if (lat) {
#pragma unroll
            for (int j = 0; j < 4; ++j) *(LAS u32x4*)(lds + QS + sr * RQ + (j * 8 + c8) * 16) = rq[j];
        }
        if (w == 0) {
            const float lf = fminf(g_f, 0.f) - __logf(1.f + __expf(-fabsf(g_f)));
            const float bc = wave_scan_add(lf);
            const float a = g_i - bc;
            const float pm = wave_scan_max(a);
            const float M = fmaxf(m_in, pm);
            const float M63 = __int_as_float(__builtin_amdgcn_readlane(__float_as_int(M), 63)), b63 = __int_as_float(__builtin_amdgcn_readlane(__float_as_int(bc), 63));
            const int p = dir ? 63 - lane : lane;
            *(LAS float*)(lds + SC_A + p * 4) = a;
            *(LAS float*)(lds + SC_M + p * 4) = M;
            *(LAS float*)(lds + SC_WI + p * 4) = __expf(m_in - M);
            *(LAS float*)(lds + SC_TH + p * 4) = __expf(-(bc + M));
            *(LAS float*)(lds + SC_WS + p * 4) = __expf(a - M63);
            if (lane == 0) *(LAS float*)(lds + SC_WC) = __expf(m_in - M63);
            m_in = b63 + M63;
        }
        __syncthreads();
        if (ci > 0 && tid < 256) *(LAS float*)(lds + NV + tid * 4) += *(LAS float*)(lds + NV2 + tid * 4);
        {
            const float wsv = *(LAS float*)(lds + SC_WS + sr * 4);
            u32x4 o;
            o.x = cvt_pk_bf16(bf_lo(rv.x) * wsv, bf_hi(rv.x) * wsv); o.y = cvt_pk_bf16(bf_lo(rv.y) * wsv, bf_hi(rv.y) * wsv);
            o.z = cvt_pk_bf16(bf_lo(rv.z) * wsv, bf_hi(rv.z) * wsv); o.w = cvt_pk_bf16(bf_lo(rv.w) * wsv, bf_hi(rv.w) * wsv);
            *(LAS u32x4*)(lds + VWS + sr * RV + c8 * 16) = o;
        }
        if (pend_b) { CV_FINISH(); pend_b = false; }
        if (ci + 1 < 36) ML_LOAD(ci + 1);
        CV_ISSUE();
        const int tb0 = 2 * (w >> 2);
        if (lat) {
            const int s0 = 16 * (w & 3);
            f32x4 accS[2] = {(f32x4){0.f, 0.f, 0.f, 0.f}, (f32x4){0.f, 0.f, 0.f, 0.f}};
#pragma unroll 2
            for (int ks = 0; ks < 8; ++ks) {
                const bf16x8 A = *(const LAS bf16x8*)(lds + KS + (s0 + i16) * RQ + (32 * ks + 8 * g) * 2);
#pragma unroll
                for (int tb = 0; tb < 2; ++tb) {
                    const bf16x8 B = *(const LAS bf16x8*)(lds + QS + (16 * (tb0 + tb) + i16) * RQ + (32 * ks + 8 * g) * 2);
                    accS[tb] = __builtin_amdgcn_mfma_f32_16x16x32_bf16(A, B, accS[tb], 0, 0, 0);
                }
            }
#pragma unroll
            for (int tb = 0; tb < 2; ++tb) {
                const int tp = 16 * (tb0 + tb) + i16;
                const float Mt = *(LAS float*)(lds + SC_M + tp * 4);
                float v[4];
#pragma unroll
                for (int r = 0; r < 4; ++r) {
                    const int sp = s0 + 4 * g + r;
                    const bool ok = dir ? (sp >= tp) : (sp <= tp);
                    const float as = *(LAS float*)(lds + SC_A + sp * 4);
                    v[r] = ok ? accS[tb][r] * __expf(as - Mt) : 0.f;
                }
                u32x2 o; o.x = cvt_pk_bf16(v[0], v[1]); o.y = cvt_pk_bf16(v[2], v[3]);
                *(LAS u32x2*)(lds + SS + tp * RV + (s0 + 4 * g) * 2) = o;
            }
        }
        __syncthreads();
        f32x4 accO[2] = {(f32x4){0.f, 0.f, 0.f, 0.f}, (f32x4){0.f, 0.f, 0.f, 0.f}};
        const int v0 = 16 * (w & 3);
        if (lat) {
            {
                const int t = sr, part = c8;
                const u32x4 sv = *(const LAS u32x4*)(lds + SS + t * RV + part * 16);
                float rs = bf_lo(sv.x) + bf_hi(sv.x) + bf_lo(sv.y) + bf_hi(sv.y) + bf_lo(sv.z) + bf_hi(sv.z) + bf_lo(sv.w) + bf_hi(sv.w);
                float qn = 0.f;
#pragma unroll
                for (int j = 0; j < 4; ++j) {
                    const u32x4 qv = *(const LAS u32x4*)(lds + QS + t * RQ + part * 64 + j * 16);
                    const f32x4 n0 = *(const LAS f32x4*)(lds + NV + (part * 32 + j * 8) * 4), n1 = *(const LAS f32x4*)(lds + NV + (part * 32 + j * 8 + 4) * 4);
                    qn += bf_lo(qv.x) * n0[0] + bf_hi(qv.x) * n0[1] + bf_lo(qv.y) * n0[2] + bf_hi(qv.y) * n0[3]
                        + bf_lo(qv.z) * n1[0] + bf_hi(qv.z) * n1[1] + bf_lo(qv.w) * n1[2] + bf_hi(qv.w) * n1[3];
                }
                rs = sum8_dpp(rs); qn = sum8_dpp(qn);
                if (part == 0) {
                    const float den = rs + *(LAS float*)(lds + SC_WI + t * 4) * qn;
                    *(LAS float*)(lds + SC_DEN + t * 4) = 1.f / fmaxf(fabsf(den), *(LAS float*)(lds + SC_TH + t * 4));
                }
            }
#pragma unroll 2
            for (int ks = 0; ks < 8; ++ks) {
                const bf16x8 A = *(const LAS bf16x8*)(lds + CTS + (v0 + i16) * RQ + (32 * ks + 8 * g) * 2);
#pragma unroll
                for (int tb = 0; tb < 2; ++tb) {
                    const bf16x8 B = *(const LAS bf16x8*)(lds + QS + (16 * (tb0 + tb) + i16) * RQ + (32 * ks + 8 * g) * 2);
                    accO[tb] = __builtin_amdgcn_mfma_f32_16x16x32_bf16(A, B, accO[tb], 0, 0, 0);
                }
            }
#pragma unroll
            for (int tb = 0; tb < 2; ++tb) accO[tb] *= *(LAS float*)(lds + SC_WI + (16 * (tb0 + tb) + i16) * 4);
#pragma unroll
            for (int s2 = 0; s2 < 2; ++s2) {
                const bf16x8 A = tr_pair(lds + VS + (32 * s2 + 8 * g + q4) * RV + (v0 + 4 * p4) * 2, 4 * RV);
#pragma unroll
                for (int tb = 0; tb < 2; ++tb) {
                    const bf16x8 B = *(const LAS bf16x8*)(lds + SS + (16 * (tb0 + tb) + i16) * RV + (32 * s2 + 8 * g) * 2);
                    accO[tb] = __builtin_amdgcn_mfma_f32_16x16x32_bf16(A, B, accO[tb], 0, 0, 0);
                }
            }
        }
        __syncthreads();
        if (lat) {
#pragma unroll
            for (int tb = 0; tb < 2; ++tb) {
                const int tp = 16 * (tb0 + tb) + i16;
                const float rd = *(LAS float*)(lds + SC_DEN + tp * 4);
                u32x2 o; o.x = cvt_pk_bf16(accO[tb][0] * rd, accO[tb][1] * rd); o.y = cvt_pk_bf16(accO[tb][2] * rd, accO[tb][3] * rd);
                *(u32x2*)(Hout + (size_t)(row0 + tp) * 2048 + h * 512 + vs * 64 + v0 + 4 * g) = o;
            }
        }
        CV_FINISH();
        if ((ci % 3) == 0) { CV_ISSUE(); pend_b = true; }
        {
            const float wcv = *(LAS float*)(lds + SC_WC);
            const int k0 = 32 * w;
#pragma unroll
            for (int a = 0; a < 2; ++a)
#pragma unroll
                for (int v = 0; v < 4; ++v) accC[a][v] *= wcv;
#pragma unroll
            for (int s2 = 0; s2 < 2; ++s2) {
                bf16x8 A[2], B[4];
#pragma unroll
                for (int a = 0; a < 2; ++a) A[a] = tr_pair(lds + KS + (32 * s2 + 8 * g + q4) * RQ + (k0 + 16 * a + 4 * p4) * 2, 4 * RQ);
#pragma unroll
                for (int v = 0; v < 4; ++v) B[v] = tr_pair(lds + VWS + (32 * s2 + 8 * g + q4) * RV + (16 * v + 4 * p4) * 2, 4 * RV);
#pragma unroll
                for (int a = 0; a < 2; ++a)
#pragma unroll
                    for (int v = 0; v < 4; ++v) accC[a][v] = __builtin_amdgcn_mfma_f32_16x16x32_bf16(A[a], B[v], accC[a][v], 0, 0, 0);
            }
#pragma unroll
            for (int a = 0; a < 2; ++a)
#pragma unroll
                for (int v = 0; v < 4; ++v) {
                    u32x2 o; o.x = cvt_pk_bf16(accC[a][v][0], accC[a][v][1]); o.y = cvt_pk_bf16(accC[a][v][2], accC[a][v][3]);
                    *(LAS u32x2*)(lds + CTS + (16 * v + i16) * RQ + (k0 + 16 * a + 4 * g) * 2) = o;
                }
            {
                const int kk_ = tid & 255, hf_ = tid >> 8;
                float nv = hf_ ? 0.f : wcv * *(LAS float*)(lds + NV + kk_ * 4);
#pragma unroll 8
                for (int s = 0; s < 32; ++s) nv += *(LAS float*)(lds + SC_WS + (hf_ * 32 + s) * 4) * bf_s(*(const LAS unsigned short*)(lds + KS + (hf_ * 32 + s) * RQ + kk_ * 2));
                *(LAS float*)(lds + (hf_ ? NV2 : NV) + kk_ * 4) = nv;
            }
        }
        __syncthreads();
    }
    if (pend_b) CV_FINISH();
#undef ML_ROW0
#undef ML_LOAD
}
}

__global__ void __launch_bounds__(NTHREADS, 2) fwd(Args args) {
    extern __shared__ __attribute__((aligned(16))) unsigned char lds_raw[];
    LAS unsigned char* lds = (LAS unsigned char*)lds_raw;
    volatile LAS unsigned* MISC = (volatile LAS unsigned*)(lds + MISC_OFF);
    const int wave = __builtin_amdgcn_readfirstlane((int)threadIdx.x >> 6);
    const int G = gridDim.x, bx = blockIdx.x;
    const int vcu = (G % 8 == 0) ? (bx % 8) * (G / 8) + bx / 8 : bx;
    unsigned char* ws = args.ws;
    unsigned* ctl = (unsigned*)(ws + WS_CTL);
    { const int tid0 = wave * 64 + lane_id_(); for (int u = tid0; u < 256; u += NTHREADS) MISC[u] = 0u; }
    __syncthreads();
    XcdBarrier bar = xcd_barrier_post(ctl + CW_BAR, MISC, wave == 0 && lane_id_() == 0);
    const int lo = args.ph_lo, hi = args.ph_hi;
#define IN(k) (lo <= (k) && (k) < hi)
#define NREP(k) (1 + ((REP_MASK >> (k)) & 1))
#define SEAM(k) do { if (IN(k) && IN((k) + 1)) xcd_barrier(bar, wave); } while (0)

    const float* x = args.in[0]; const float* cvec = args.in[1]; const float* ctx = args.in[2]; const float* c_ctx = args.in[3];
    const float* w_mod = args.in[4]; const float* b_mod = args.in[5]; const float* g_norm1 = args.in[6]; const float* g_norm2 = args.in[7];
    const float* w_in = args.in[8]; const float* b_in = args.in[9]; const float* g_q = args.in[10]; const float* g_k = args.in[11]; const float* g_mh = args.in[12];
    const float* w_br_m = args.in[13]; const float* w_br_a = args.in[14]; const float* w_out = args.in[15];
    const float* w_router = args.in[16]; const float* b_router = args.in[17]; const float* w_gu = args.in[18]; const float* b_gu = args.in[19];
    const float* w_dn = args.in[20]; const float* b_dn = args.in[21];
    float* out = args.out;
    float* MOD = (float*)(ws + WS_MOD); float* BINP = (float*)(ws + WS_BINP);
    bf16_t* WTIN = (bf16_t*)(ws + WS_WTIN); bf16_t* WTBRM = (bf16_t*)(ws + WS_WTBRM); bf16_t* WTBRA = (bf16_t*)(ws + WS_WTBRA); bf16_t* WTOUT = (bf16_t*)(ws + WS_WTOUT);
    unsigned char* WTGU = ws + WS_WTGU; unsigned char* WTDN = ws + WS_WTDN;
    bf16_t* U = (bf16_t*)(ws + WS_U); bf16_t* PM = (bf16_t*)(ws + WS_PM); float* GATES = (float*)(ws + WS_GATES);
    unsigned char* OG8 = ws + WS_AQ;        bf16_t* AK = (bf16_t*)(ws + WS_AK); bf16_t* VV = (bf16_t*)(ws + WS_VV); bf16_t* KR = (bf16_t*)(ws + WS_KR); bf16_t* QR = (bf16_t*)(ws + WS_QR);
    unsigned char* MG = ws + WS_MG; bf16_t* AO = (bf16_t*)(ws + WS_AO); bf16_t* HF = (bf16_t*)(ws + WS_HF); bf16_t* HB = (bf16_t*)(ws + WS_HB);
    bf16_t* MX = (bf16_t*)(ws + WS_MX); bf16_t* MRG = (bf16_t*)(ws + WS_MRG); unsigned char* U2 = ws + WS_U2;
    int* TOPE = (int*)(ws + WS_TOPE); int* TOPP = (int*)(ws + WS_TOPP); float* TOPW = (float*)(ws + WS_TOPW); int* LIST = (int*)(ws + WS_LIST);
    unsigned char* HID = ws + WS_HID; bf16_t* Y = (bf16_t*)(ws + WS_Y); unsigned char* WTIN8 = ws + WS_WTIN8; unsigned char* U8 = ws + WS_U8;
    unsigned char* W8BRM = ws + WS_W8BRM; unsigned char* W8BRA = ws + WS_W8BRA; unsigned char* W8OUT = ws + WS_W8OUT; unsigned char* MX8 = ws + WS_MX8; unsigned char* AO8 = ws + WS_AO8; unsigned char* MRG8 = ws + WS_MRG8; float* ROPE = (float*)(ws + WS_ROPE); bf16_t* HX1 = (bf16_t*)(ws + WS_HX1);
    unsigned* ECNT = ctl + CW_CNT;

    if (IN(0)) {
        const int lane = lane_id_(), tid = wave * 64 + lane; (void)tid; (void)lane;
_Pragma("unroll")
    for (int rep_ = 0; rep_ < NREP(0); ++rep_) { if (rep_) xcd_barrier(bar, wave);
        if (bx < 192) {
            LAS float* sc = (LAS float*)lds;
            LAS float* red = (LAS float*)(lds + 5 * 2048 * 4);
            for (int idx = tid; idx < 5 * 2048; idx += NTHREADS) { const int r = idx >> 11, k = idx & 2047; const float v = (r < 4) ? cvec[r * 2048 + k] : c_ctx[k]; sc[idx] = v / (1.f + __expf(-v)); }
            __syncthreads();
            const int cq = lane & 15, kr = lane >> 4;
            f32x4 ac[5];
#pragma unroll
            for (int r = 0; r < 5; ++r) ac[r] = (f32x4){0.f, 0.f, 0.f, 0.f};
            const float* wp = w_mod + (size_t)(wave * 256 + kr) * 12288 + bx * 64 + cq * 4;
#pragma unroll 8
            for (int kk = 0; kk < 64; ++kk) {
                const f32x4 wv = *(const f32x4*)(wp + (size_t)kk * 4 * 12288); const int k = wave * 256 + kk * 4 + kr;
#pragma unroll
                for (int r = 0; r < 5; ++r) ac[r] += wv * sc[r * 2048 + k];
            }
#pragma unroll
            for (int r = 0; r < 5; ++r) {
#pragma unroll
                for (int j = 0; j < 4; ++j) {
                    float v = ac[r][j];
                    { auto r_ = __builtin_amdgcn_permlane16_swap(__float_as_uint(v), __float_as_uint(v), false, false); v = __uint_as_float(r_[0]) + __uint_as_float(r_[1]); }
                    { auto r_ = __builtin_amdgcn_permlane32_swap(__float_as_uint(v), __float_as_uint(v), false, false); v = __uint_as_float(r_[0]) + __uint_as_float(r_[1]); }
                    ac[r][j] = v;
                }
                if (kr == 0) *(LAS f32x4*)(red + (wave * 5 + r) * 64 + cq * 4) = ac[r];
            }
            __syncthreads();
            if (tid < 320) { const int r = tid >> 6, l = tid & 63; float s = 0.f;
#pragma unroll
                for (int ww = 0; ww < 8; ++ww) s += red[(ww * 5 + r) * 64 + l];
                MOD[r * 12288 + bx * 64 + l] = s + b_mod[bx * 64 + l]; }
            __syncthreads();
        }
        const int gtid = bx * NTHREADS + tid, gthreads = G * NTHREADS;
        for (int n = gtid; n < NP; n += gthreads) {
            float v = 0.f;
            if (n < 6144) v = b_in[n]; else if (n < 13312) v = b_in[n + 16]; else if (n < 13328) v = b_in[6144 + (n - 13312)];
            BINP[n] = v;
        }
        for (int idx = gtid; idx < (NP - F_IN) * (D / 8); idx += gthreads) *(u32x4*)(WTIN + (size_t)F_IN * D + (size_t)idx * 8) = (u32x4){0u, 0u, 0u, 0u};
        {
            const int nq = lane & 7, ks = lane >> 3;
            constexpr int T_IN = 16 * 417, T_SQ = 16 * 64;
            constexpr int T_ALL = T_IN + 3 * T_SQ;
            const bool wt = (G == 256);
            const int nw = wt ? 2560 : G * 8, nstream = (wt && bx >= 192) ? 2 : 1;
#pragma unroll 1
            for (int vs_ = 0; vs_ < nstream; ++vs_) {
            const int gw = !wt ? bx * 8 + wave : (bx < 192 ? bx * 8 + wave : 1536 + ((bx - 192) * 8 + wave) * 2 + vs_);
#pragma unroll 1
            for (int t = gw; t < T_ALL; t += nw) {
                const float* src; int N, nb, kb, mode; unsigned char* dstb; bool f8;
                if (t < T_IN) { nb = t % 417; kb = t / 417; src = w_in; N = F_IN; dstb = (unsigned char*)WTIN; mode = 1; f8 = false; }
                else { const int q = t - T_IN, mtx = q / T_SQ, r = q % T_SQ; nb = r & 63; kb = r >> 6; N = 2048; mode = 0; f8 = true;
                    src = mtx == 0 ? w_br_m : (mtx == 1 ? w_br_a : w_out); dstb = mtx == 0 ? W8BRM : (mtx == 1 ? W8BRA : W8OUT); }
                const int n = nb * 32 + nq * 4;
                if (n < N) {
                    const float* sp = src + (size_t)(kb * 128 + ks * 16) * N + n;
                    f32x4 v[16];
#pragma unroll
                    for (int kk = 0; kk < 16; ++kk) v[kk] = *(const f32x4*)(sp + (size_t)kk * N);
                    int nd = n;
                    if (mode == 1) nd = n < 6144 ? n : (n < 6160 ? 13312 + (n - 6144) : n - 16);
                    if (mode == 2) { const int j = n & 2047; nd = (j >> 7) * 256 + ((n >> 11) << 7) + (j & 127); }
                    bool f8l = f8;
                    if (mode == 1 && nd >= 2048 && nd < 13312) { f8l = true; nd -= 2048; dstb = WTIN8; }
                    if (f8l) {
                        unsigned char* dp = dstb + (size_t)nd * D + kb * 128 + ks * 16;
#pragma unroll
                        for (int j = 0; j < 4; ++j) {
                            u32x4 w;
                            w.x = pk4_fp8(v[0][j] * WSCALE, v[1][j] * WSCALE, v[2][j] * WSCALE, v[3][j] * WSCALE);
                            w.y = pk4_fp8(v[4][j] * WSCALE, v[5][j] * WSCALE, v[6][j] * WSCALE, v[7][j] * WSCALE);
                            w.z = pk4_fp8(v[8][j] * WSCALE, v[9][j] * WSCALE, v[10][j] * WSCALE, v[11][j] * WSCALE);
                            w.w = pk4_fp8(v[12][j] * WSCALE, v[13][j] * WSCALE, v[14][j] * WSCALE, v[15][j] * WSCALE);
                            *(u32x4*)(dp + (size_t)j * D) = w;
                        }
                    } else {
                        unsigned char* dp = dstb + ((size_t)nd * D + kb * 128 + ks * 16) * 2;
#pragma unroll
                        for (int j = 0; j < 4; ++j) {
                            u32x4 w0, w1;
                            w0.x = cvt_pk_bf16(v[0][j], v[1][j]); w0.y = cvt_pk_bf16(v[2][j], v[3][j]); w0.z = cvt_pk_bf16(v[4][j], v[5][j]); w0.w = cvt_pk_bf16(v[6][j], v[7][j]);
                            w1.x = cvt_pk_bf16(v[8][j], v[9][j]); w1.y = cvt_pk_bf16(v[10][j], v[11][j]); w1.z = cvt_pk_bf16(v[12][j], v[13][j]); w1.w = cvt_pk_bf16(v[14][j], v[15][j]);
                            *(u32x4*)(dp + (size_t)j * D * 2) = w0; *(u32x4*)(dp + (size_t)j * D * 2 + 16) = w1;
                        }
                    }
                }
            }
            }
        }
    } }
    SEAM(0);

    if (IN(1)) {
        const int lane = lane_id_(), tid = wave * 64 + lane; (void)tid; (void)lane;
_Pragma("unroll")
    for (int rep_ = 0; rep_ < NREP(1); ++rep_) { if (rep_) xcd_barrier(bar, wave);
        if (bx == G - 1) {
            for (int i = tid; i < 2048; i += 512) {
                float sn_, cs_; sincosf((float)(i >> 5) * __expf(-9.210340371976184f * (float)(i & 31) * (1.f / 32.f)), &sn_, &cs_);
                ROPE[i] = cs_; ROPE[2048 + i] = sn_;
            }
        }
        for (int row = bx * 8 + wave; row < NROW; row += G * 8) {
            const float* src = row < NLAT ? x + (size_t)row * D : ctx + (size_t)(row - NLAT) * D;
            const float* md = MOD + (size_t)(row < NLAT ? (row >> 11) : 4) * 12288;
            f32x4 v[8]; float ss = 0.f;
#pragma unroll
            for (int i = 0; i < 8; ++i) { v[i] = *(const f32x4*)(src + lane * 4 + 256 * i); ss += v[i][0] * v[i][0] + v[i][1] * v[i][1] + v[i][2] * v[i][2] + v[i][3] * v[i][3]; }
            ss = wave_sum(ss);
            const float rstd = rsqrtf(ss * (1.f / D) + EPS);
#pragma unroll
            for (int i = 0; i < 8; ++i) {
                const int c = lane * 4 + 256 * i;
                const f32x4 gg = *(const f32x4*)(g_norm1 + c), sh = *(const f32x4*)(md + c), sc = *(const f32x4*)(md + 2048 + c);
                const f32x4 y = v[i] * rstd * gg; const f32x4 uu = y * (sc + 1.f) + sh;
                u32x2 o; o.x = cvt_pk_bf16(uu[0], uu[1]); o.y = cvt_pk_bf16(uu[2], uu[3]);
                *(u32x2*)(U + (size_t)row * D + c) = o;
                *(unsigned*)(U8 + (size_t)row * D + c) = pk4_fp8(uu[0], uu[1], uu[2], uu[3]);
            }
        }
    } }
    SEAM(1);

    if (IN(2)) {
        const int lane = lane_id_(), tid = wave * 64 + lane; (void)tid; (void)lane;
_Pragma("unroll")
    for (int rep_ = 0; rep_ < NREP(2); ++rep_) { if (rep_) xcd_barrier(bar, wave);
        {
            SchedInprojA S{G, bx};
            g8::OpsPlain O{U, WTIN, D};
            EpiInprojT<false> E{PM, QR, KR, VV, MG, OG8, GATES, BINP, 1.f, g_q, g_k, ROPE, lds};
            g8::gemm_phase<EpiInprojT<false>, SchedInprojA, g8::OpsPlain>(lds, D * 2, S, O, E, wave);
        }
        {
            SchedInprojB S{G, (G == 256) ? ((bx + 256 - 56) & 255) : bx};
            OpsPlain8 O{U8, WTIN8, 8};
            EpiInprojT<true> E{PM, QR, KR, VV, MG, OG8, GATES, BINP, WINV, g_q, g_k, ROPE, lds};
            g8::gemm_phase<EpiInprojT<true>, SchedInprojB, OpsPlain8, true>(lds, D, S, O, E, wave);
        }
    } }
    SEAM(2);


    using ml::T_GU; using ml::T_CONV;
    if (IN(4)) {
        const int lane = lane_id_(), tid = wave * 64 + lane; (void)tid; (void)lane;
        const bool att_first = (vcu & 1) != 0;
#define ATT_BLOCK() do { _Pragma("unroll 1") for (int rep_ = 0; rep_ < NREP(12); ++rep_) { \
            for (int L = vcu; L < 512; L += G) { \
                const int pair = L >> 5, r = L & 31, b = pair >> 2, kvh = pair & 3, hq = kvh * 4 + (r >> 3), qb = r & 7; \
                const size_t qoff = ((size_t)(b * TSEQ + qb * 256)) * 2048 + hq * 128; \
                const size_t koff = ((size_t)b * KVLEN) * 512 + kvh * 128; \
                att::attn_dense_body(QR + qoff, KR + koff, VV + koff, AO8 + qoff, KVLEN, (char*)lds_raw, lds, wave); \
            } } } while (0)
        if (att_first) { ATT_BLOCK(); __syncthreads(); }
#pragma unroll 1
        for (int rep_ = 0; rep_ < NREP(4); ++rep_) {
            ml::Conv cvs{w_gu, w_dn, WTGU, WTDN, bx * 8 + wave, G * 8};
            for (int un = vcu; un < 256; un += G) {
                const int bh = un >> 4, dir = (un >> 3) & 1, vs = un & 7;
                ml::mlstm_unit(lds, PM, GATES, dir ? HB : HF, bh >> 2, bh & 3, dir, vs, cvs, wave);
            }
            {
                f32x4 cv[16];
#pragma unroll 1
                while (cvs.t < ml::T_CONV) { CV_ISSUE(); CV_FINISH(); }
            }
        }
        __syncthreads();
        if (!att_first) { ATT_BLOCK(); }
#undef ATT_BLOCK
    }
    SEAM(4);

    if (IN(5)) {
        const int lane = lane_id_(), tid = wave * 64 + lane; (void)tid; (void)lane;
_Pragma("unroll")
    for (int rep_ = 0; rep_ < NREP(5); ++rep_) { if (rep_) xcd_barrier(bar, wave);
        for (int it = bx * 8 + wave; it < NLAT * 4; it += G * 8) {
            const int tok = it >> 2, hh = it & 3;
            const size_t off = (size_t)tok * 2048 + hh * 512 + lane * 8;
            const u32x4 a = *(const u32x4*)(HF + off), bq = *(const u32x4*)(HB + off);
            float hs[8];
            hs[0] = bf_lo(a.x) + bf_lo(bq.x); hs[1] = bf_hi(a.x) + bf_hi(bq.x); hs[2] = bf_lo(a.y) + bf_lo(bq.y); hs[3] = bf_hi(a.y) + bf_hi(bq.y);
            hs[4] = bf_lo(a.z) + bf_lo(bq.z); hs[5] = bf_hi(a.z) + bf_hi(bq.z); hs[6] = bf_lo(a.w) + bf_lo(bq.w); hs[7] = bf_hi(a.w) + bf_hi(bq.w);
            float ss = 0.f;
#pragma unroll
            for (int j = 0; j < 8; ++j) ss += hs[j] * hs[j];
            ss = wave_sum(ss);
            const float rstd = rsqrtf(ss * (1.f / 512.f) + EPS);
            const u32x2 ov = *(const u32x2*)(OG8 + (size_t)tok * 2048 + hh * 512 + lane * 8);
            const f32x4 g0 = *(const f32x4*)(g_mh + hh * 512 + lane * 8), g1 = *(const f32x4*)(g_mh + hh * 512 + lane * 8 + 4);
            float op[8] = {(float)(ov.x & 0xffu), (float)((ov.x >> 8) & 0xffu), (float)((ov.x >> 16) & 0xffu), (float)(ov.x >> 24), (float)(ov.y & 0xffu), (float)((ov.y >> 8) & 0xffu), (float)((ov.y >> 16) & 0xffu), (float)(ov.y >> 24)};
            float r[8];
#pragma unroll
            for (int j = 0; j < 8; ++j) r[j] = hs[j] * (rstd * (1.f / 255.f)) * (j < 4 ? g0[j] : g1[j - 4]) * op[j];
            u32x2 o; o.x = pk4_fp8(r[0], r[1], r[2], r[3]); o.y = pk4_fp8(r[4], r[5], r[6], r[7]);
            *(u32x2*)(MX8 + off) = o;
        }
    } }
    SEAM(5);

    if (IN(6)) {
        const int lane = lane_id_(), tid = wave * 64 + lane; (void)tid; (void)lane;
_Pragma("unroll")
    for (int rep_ = 0; rep_ < NREP(6); ++rep_) { if (rep_) xcd_barrier(bar, wave);
        SchedDual S{G, bx};
        OpsDual O{MX8, AO8, W8BRM, W8BRA};
        EpiMerge E{MG, MRG8};
        g8::gemm_phase<EpiMerge, SchedDual, OpsDual, true>(lds, D, S, O, E, wave);
    } }
    SEAM(6);

    if (IN(7)) {
        const int lane = lane_id_(), tid = wave * 64 + lane; (void)tid; (void)lane;
_Pragma("unroll")
    for (int rep_ = 0; rep_ < NREP(7); ++rep_) { if (rep_) xcd_barrier(bar, wave);
        SchedSquare S{G, bx, 32, 8};
        OpsPlain8 O{MRG8, W8OUT, 0};
        EpiOut E{x, MOD, HX1, 1.f / (WSCALE * MRG_SCALE)};
        g8::gemm_phase<EpiOut, SchedSquare, OpsPlain8, true>(lds, D, S, O, E, wave);
    } }
    SEAM(7);

    if (IN(8)) {
        const int lane = lane_id_(), tid = wave * 64 + lane; (void)tid; (void)lane;
        LAS float* ut = (LAS float*)lds;
        LAS float* part = (LAS float*)(lds + 65536);
        LAS float* lg = (LAS float*)(lds + 65536 + 16384);
        LAS int* asg_tok = (LAS int*)(lds + 65536 + 16384 + 1024);
        LAS int* asg_e = asg_tok + 256; LAS float* asg_w = (LAS float*)(asg_e + 256);
        LAS int* hist = asg_e + 512; LAS int* hbase = hist + 32;
        int nit = 0;
#define P8_FLUSH() do {     \
            const int nas = nit * 32; \
            if (tid < 32) hist[tid] = 0; \
            __syncthreads(); \
            int my_e = 0, my_rank = 0; \
            if (tid < nas) { my_e = asg_e[tid]; my_rank = atomicAdd((int*)&hist[my_e], 1); } \
            __syncthreads(); \
            if (tid < 32) { const int c_ = hist[tid]; hbase[tid] = c_ ? (int)atomicAdd(&ECNT[tid], (unsigned)c_) : 0; } \
            __syncthreads(); \
            if (tid < nas) { \
                const int pos_ = hbase[my_e] + my_rank, tok_ = asg_tok[tid]; \
                LIST[my_e * NLAT + pos_] = tok_; \
                TOPE[tok_ * 4 + (tid & 3)] = my_e; TOPP[tok_ * 4 + (tid & 3)] = pos_; TOPW[tok_ * 4 + (tid & 3)] = asg_w[tid]; \
            } \
            __syncthreads(); nit = 0; } while (0)
        const int e = lane & 31, jh = lane >> 5, jb = wave * 256 + jh * 128;
        float wv[128];
        {
            const float* wrp = w_router + (size_t)jb * 32 + e;
#pragma unroll
            for (int q = 0; q < 128; ++q) wv[q] = wrp[q * 32];
        }
        u32x4 hv[4];
#define P8_LOADV(T0) do { const bf16_t* src_ = HX1 + (size_t)((T0) + wave) * D; _Pragma("unroll") for (int i = 0; i < 4; ++i) hv[i] = *(const u32x4*)(src_ + lane * 8 + 512 * i); } while (0)
        LAS float* gsv = (LAS float*)(lds + 96 * 1024); LAS float* shv = (LAS float*)(lds + 104 * 1024);
        const int nblk = NLAT / 8, per_ = (nblk + G - 1) / G, blk0 = bx * per_, blk1 = (blk0 + per_ < nblk) ? blk0 + per_ : nblk;
        int cur_b = -1;
        if (blk0 < blk1) P8_LOADV(blk0 * 8);
        for (int blk = blk0; blk < blk1; ++blk) {
            const int t0 = blk * 8;
            if ((t0 >> 11) != cur_b) {
                cur_b = t0 >> 11;
                const float* md = MOD + (size_t)cur_b * 12288; const int c = tid * 4;
                const f32x4 gg = *(const f32x4*)(g_norm2 + c), sh = *(const f32x4*)(md + 6144 + c), sc = *(const f32x4*)(md + 8192 + c);
                *(LAS f32x4*)(gsv + c) = gg * (sc + 1.f); *(LAS f32x4*)(shv + c) = sh;
                __syncthreads();
            }
            {
                const int tok = t0 + wave;
                f32x4 v[8]; float ss = 0.f;
#pragma unroll
                for (int i = 0; i < 4; ++i) {
                    v[2 * i] = (f32x4){bf_lo(hv[i].x), bf_hi(hv[i].x), bf_lo(hv[i].y), bf_hi(hv[i].y)}; v[2 * i + 1] = (f32x4){bf_lo(hv[i].z), bf_hi(hv[i].z), bf_lo(hv[i].w), bf_hi(hv[i].w)};
                }
#pragma unroll
                for (int i = 0; i < 8; ++i) ss += v[i][0] * v[i][0] + v[i][1] * v[i][1] + v[i][2] * v[i][2] + v[i][3] * v[i][3];
                ss = wave_sum(ss);
                const float rstd = rsqrtf(ss * (1.f / D) + EPS);
#pragma unroll
                for (int i = 0; i < 4; ++i) {
                    const int c = lane * 8 + 512 * i;
                    const f32x4 u0 = v[2 * i] * rstd * *(const LAS f32x4*)(gsv + c) + *(const LAS f32x4*)(shv + c);
                    const f32x4 u1 = v[2 * i + 1] * rstd * *(const LAS f32x4*)(gsv + c + 4) + *(const LAS f32x4*)(shv + c + 4);
                    *(LAS f32x4*)(ut + wave * 2048 + c) = u0; *(LAS f32x4*)(ut + wave * 2048 + c + 4) = u1;
                    u32x2 w8; w8.x = pk4_fp8(u0[0], u0[1], u0[2], u0[3]); w8.y = pk4_fp8(u1[0], u1[1], u1[2], u1[3]);
                    *(u32x2*)(U2 + (size_t)tok * D + c) = w8;
                }
            }
            if (blk + 1 < blk1) P8_LOADV(t0 + 8);
            __syncthreads();
            {
                float a[8] = {0.f, 0.f, 0.f, 0.f, 0.f, 0.f, 0.f, 0.f};
#pragma unroll
                for (int th = 0; th < 8; th += 4) {
                    f32x4 ua[4], ub[4];
#pragma unroll
                    for (int tk = 0; tk < 4; ++tk) ua[tk] = *(const LAS f32x4*)(ut + (th + tk) * 2048 + jb);
#pragma unroll
                    for (int jj = 0; jj < 128; jj += 8) {
#pragma unroll
                        for (int tk = 0; tk < 4; ++tk) ub[tk] = *(const LAS f32x4*)(ut + (th + tk) * 2048 + jb + jj + 4);
#pragma unroll
                        for (int tk = 0; tk < 4; ++tk) a[th + tk] += ua[tk][0] * wv[jj] + ua[tk][1] * wv[jj + 1] + ua[tk][2] * wv[jj + 2] + ua[tk][3] * wv[jj + 3];
                        if (jj + 8 < 128) {
#pragma unroll
                            for (int tk = 0; tk < 4; ++tk) ua[tk] = *(const LAS f32x4*)(ut + (th + tk) * 2048 + jb + jj + 8);
                        }
#pragma unroll
                        for (int tk = 0; tk < 4; ++tk) a[th + tk] += ub[tk][0] * wv[jj + 4] + ub[tk][1] * wv[jj + 5] + ub[tk][2] * wv[jj + 6] + ub[tk][3] * wv[jj + 7];
                    }
                }
#pragma unroll
                for (int tk = 0; tk < 8; ++tk) part[((wave * 2 + jh) * 8 + tk) * 32 + e] = a[tk];
            }
            __syncthreads();
            {
                const int tok = t0 + wave;
                float v = -INFINITY;
                if (lane < 32) { float s = b_router[lane];
#pragma unroll
                    for (int p = 0; p < 16; ++p) s += part[(p * 8 + wave) * 32 + lane];
                    v = s; }
                float tl[4]; int te[4];
#pragma unroll
                for (int k = 0; k < 4; ++k) {
                    const float mx = wave_max(v);
                    const unsigned long long bm = __ballot(v == mx);
                    const int e = __ffsll((long long)bm) - 1;
                    tl[k] = mx; te[k] = e;
                    if (lane == e) v = -INFINITY;
                }
                const float e1 = __expf(tl[1] - tl[0]), e2 = __expf(tl[2] - tl[0]), e3 = __expf(tl[3] - tl[0]);
                const float inv = 1.f / (1.f + e1 + e2 + e3);
                if (lane < 4) {
                    const int e = lane == 0 ? te[0] : (lane == 1 ? te[1] : (lane == 2 ? te[2] : te[3]));
                    const float wgt = (lane == 0 ? 1.f : (lane == 1 ? e1 : (lane == 2 ? e2 : e3))) * inv;
                    const int slot = (nit * 8 + wave) * 4 + lane;
                    asg_tok[slot] = tok; asg_e[slot] = e; asg_w[slot] = wgt;
                }
            }
            ++nit;
            __syncthreads();
            if (nit == 8) P8_FLUSH();
        }
        if (nit > 0) P8_FLUSH();
#undef P8_FLUSH
#undef P8_LOADV
    }
    SEAM(8);

    volatile LAS int* mstart = (volatile LAS int*)(MISC + 16);
    volatile LAS int* ecnt_l = (volatile LAS int*)(MISC + 52);
    volatile LAS int* texp_l = (volatile LAS int*)(MISC + 88);
    if (IN(9) || IN(10) || IN(11)) {
        const int lane = lane_id_();
        if (wave == 0) {
            const int c = lane < 32 ? (int)__hip_atomic_load(&ECNT[lane & 31], __ATOMIC_RELAXED, __HIP_MEMORY_SCOPE_AGENT) : 0;
            int n = (c + 255) >> 8;
#pragma unroll
            for (int o = 1; o < 64; o <<= 1) { const int t = __shfl_up(n, o, 64); if (lane >= o) n += t; }
            if (lane < 32) { mstart[lane + 1] = n; ecnt_l[lane] = c; }
            if (lane == 0) mstart[0] = 0;
        }
        __syncthreads();
        {
            const int tid2 = wave * 64 + lane;
            if (tid2 < 32) { const int a = mstart[tid2], b = mstart[tid2 + 1]; for (int t = a; t < b; ++t) texp_l[t] = tid2; }
        }
        __syncthreads();
    }
    if (IN(9)) {
        const int lane = lane_id_(), tid = wave * 64 + lane; (void)tid; (void)lane;
_Pragma("unroll")
    for (int rep_ = 0; rep_ < NREP(9); ++rep_) { if (rep_) xcd_barrier(bar, wave);
        SchedMoe S{G, vcu, 16, mstart, texp_l, ecnt_l, 0};
        OpsMoe1 O{U2, WTGU, LIST, ecnt_l};
        EpiMoe1 E{HID, b_gu};
        g8::gemm_phase<EpiMoe1, SchedMoe, OpsMoe1, true>(lds, D, S, O, E, wave);
    } }
    SEAM(9);
    if (IN(10)) {
        const int lane = lane_id_(), tid = wave * 64 + lane; (void)tid; (void)lane;
_Pragma("unroll")
    for (int rep_ = 0; rep_ < NREP(10); ++rep_) { if (rep_) xcd_barrier(bar, wave);
        SchedMoe S{G, vcu, 8, mstart, texp_l, ecnt_l, 1};
        OpsMoe2 O{HID, WTDN};
        EpiMoe2 E{Y, b_dn};
        g8::gemm_phase<EpiMoe2, SchedMoe, OpsMoe2, true>(lds, D, S, O, E, wave);
    } }
    SEAM(10);

    if (IN(11)) {
        const int lane = lane_id_(), tid = wave * 64 + lane; (void)tid; (void)lane;
        for (int tok = bx * 8 + wave; tok < NLAT; tok += G * 8) {
            const float* md = MOD + (size_t)(tok >> 11) * 12288 + 10240;
            size_t ro[4]; float wk[4];
#pragma unroll
            for (int k = 0; k < 4; ++k) { const int e = TOPE[tok * 4 + k]; ro[k] = ((size_t)mstart[e] * 256 + TOPP[tok * 4 + k]) * 2048; wk[k] = TOPW[tok * 4 + k] * (1.f / Y_SCALE); }
#pragma unroll
            for (int i = 0; i < 4; ++i) {
                const int c = lane * 8 + 512 * i;
                float s[8] = {0.f, 0.f, 0.f, 0.f, 0.f, 0.f, 0.f, 0.f};
#pragma unroll
                for (int k = 0; k < 4; ++k) {
                    const u32x2 yv = *(const u32x2*)((const unsigned char*)Y + ro[k] + c);
                    const auto p0 = __builtin_amdgcn_cvt_pk_f32_fp8((int)yv.x, false), p1 = __builtin_amdgcn_cvt_pk_f32_fp8((int)yv.x, true);
                    const auto p2 = __builtin_amdgcn_cvt_pk_f32_fp8((int)yv.y, false), p3 = __builtin_amdgcn_cvt_pk_f32_fp8((int)yv.y, true);
                    s[0] += wk[k] * p0[0]; s[1] += wk[k] * p0[1]; s[2] += wk[k] * p1[0]; s[3] += wk[k] * p1[1];
                    s[4] += wk[k] * p2[0]; s[5] += wk[k] * p2[1]; s[6] += wk[k] * p3[0]; s[7] += wk[k] * p3[1];
                }
                float* op = out + (size_t)tok * D + c;
                const u32x4 hq = *(const u32x4*)(HX1 + (size_t)tok * D + c);
                const f32x4 h0 = (f32x4){bf_lo(hq.x), bf_hi(hq.x), bf_lo(hq.y), bf_hi(hq.y)}, h1 = (f32x4){bf_lo(hq.z), bf_hi(hq.z), bf_lo(hq.w), bf_hi(hq.w)};
                const f32x4 g0 = *(const f32x4*)(md + c), g1 = *(const f32x4*)(md + c + 4);
                f32x4 r0, r1;
#pragma unroll
                for (int j = 0; j < 4; ++j) { r0[j] = h0[j] + g0[j] * s[j]; r1[j] = h1[j] + g1[j] * s[4 + j]; }
                *(f32x4*)op = r0; *(f32x4*)(op + 4) = r1;
            }
        }
    }
#undef IN
#undef SEAM
}

#ifndef MK_SPLIT
#define MK_SPLIT 0
#endif
constexpr int NPHASE = 12;
extern "C" void kernel_launch(void* const* d_in, const int* in_sizes, int n_in, void* d_out, int out_size, void* d_ws, size_t ws_size, hipStream_t stream) {
    static int grid = 0;
    if (grid == 0) {
        if (n_in != 22 || out_size != NLAT * D || ws_size < WS_END) { fprintf(stderr, "kernel_launch: unexpected shapes (n_in %d out %d ws %zu need %zu)\n", n_in, out_size, ws_size, (size_t)WS_END); grid = -1; return; }
        int dev = 0, cus = 0, per_cu = 0;
        if (hipGetDevice(&dev) != hipSuccess || hipDeviceGetAttribute(&cus, hipDeviceAttributeMultiprocessorCount, dev) != hipSuccess) { grid = -1; return; }
        if (hipFuncSetAttribute((const void*)fwd, hipFuncAttributeMaxDynamicSharedMemorySize, LDS_TOTAL) != hipSuccess) { fprintf(stderr, "kernel_launch: hipFuncSetAttribute failed\n"); grid = -1; return; }
        if (hipOccupancyMaxActiveBlocksPerMultiprocessor(&per_cu, (const void*)fwd, NTHREADS, LDS_TOTAL) != hipSuccess || per_cu < 1) fprintf(stderr, "kernel_launch: occupancy query says %d\n", per_cu);
        (void)hipGetLastError();
        grid = cus;
    }
    if (grid < 0) return;
    if (hipMemsetAsync((char*)d_ws + WS_CTL, 0, CTL_BYTES, stream) != hipSuccess) return;
    Args a{};
    for (int i = 0; i < 22; ++i) a.in[i] = (const float*)d_in[i];
    a.out = (float*)d_out; a.ws = (unsigned char*)d_ws;
#if MK_SPLIT
    for (int p = 0; p < NPHASE; ++p) { a.ph_lo = p; a.ph_hi = p + 1; hipLaunchKernelGGL(fwd, dim3(grid), dim3(NTHREADS), LDS_TOTAL, stream, a); }
#else
    a.ph_lo = 0; a.ph_hi = NPHASE;
    hipLaunchKernelGGL(fwd, dim3(grid), dim3(NTHREADS), LDS_TOTAL, stream, a);
#endif
}
```
